# Optimizing an MI355X kernel written in HIP

```python
import math
import jax, jax.numpy as jnp
from jax import lax
import numpy as np

D_MODEL = 1024
BATCH = 8
SEQ = 2048
DEPTH = 1
DEC_BATCH = 16
DEC_SEQ = 16
PAST_LEN = 4096

CHUNK = 64
Q_BLOCK = 128
MIX_WIDTH = D_MODEL
MLA_HEADS = 8
NOPE_DIM = 64
ROPE_DIM = 32
V_DIM = 64
MLA_WIDTH = MLA_HEADS * V_DIM
Q_LORA = 384
KV_LORA = 256
ROPE_THETA = 10000.0
ATTN_SCALE = 1.0 / math.sqrt(NOPE_DIM + ROPE_DIM)
CONV_CH = MIX_WIDTH - MLA_WIDTH
CONV_W = 31
CONV_STATE = CONV_W - 1
D_FF = -(-8 * D_MODEL // (3 * 256)) * 256
IN_WIDTH = Q_LORA + KV_LORA + ROPE_DIM + 2 * CONV_CH
EPS = 1e-6

kernel_name = "hybrid_mla_conformer_conv_stream_step"


def rms_norm(x, g):
    xf = x.astype(jnp.float32)
    y = xf * lax.rsqrt(jnp.mean(xf * xf, axis=-1, keepdims=True) + EPS)
    return y.astype(x.dtype) * g


def layer_norm(x, g, b):
    xf = x.astype(jnp.float32)
    mu = jnp.mean(xf, axis=-1, keepdims=True)
    xc = xf - mu
    y = xc * lax.rsqrt(jnp.mean(xc * xc, axis=-1, keepdims=True) + EPS)
    return y.astype(x.dtype) * g + b


def rope_angles(pos):
    inv = 1.0 / (ROPE_THETA ** (jnp.arange(0, ROPE_DIM, 2, dtype=jnp.float32) / ROPE_DIM))
    ang = pos.astype(jnp.float32)[:, None] * inv[None, :]
    return jnp.cos(ang), jnp.sin(ang)


def apply_rope(x, cos, sin):
    xf = x.astype(jnp.float32)
    x1, x2 = xf[..., : ROPE_DIM // 2], xf[..., ROPE_DIM // 2:]
    return jnp.concatenate([x1 * cos - x2 * sin, x2 * cos + x1 * sin], axis=-1).astype(x.dtype)


def latent_attend(q_lat, q_pe, c_kv, k_pe, mask):
    s = (jnp.einsum('bqhc,bkc->bhqk', q_lat, c_kv)
         + jnp.einsum('bqhr,bkr->bhqk', q_pe, k_pe)).astype(jnp.float32) * ATTN_SCALE
    if mask is not None:
        s = jnp.where(mask, s, -1e30)
    p = jax.nn.softmax(s, axis=-1).astype(c_kv.dtype)
    return jnp.einsum('bhqk,bkc->bqhc', p, c_kv)


def token_mixers(hn, pos, ckv_past, kpe_past, conv_past,
                 w_in, g_q, w_uq, g_kv, w_uk, w_uv, w_dw, b_dw, g_cn, b_cn, g_om, g_oc, w_out):
    B, S, _ = hn.shape
    proj = hn @ w_in
    cq, ckv, kpe, conv_in = jnp.split(
        proj, [Q_LORA, Q_LORA + KV_LORA, Q_LORA + KV_LORA + ROPE_DIM], axis=-1)
    cos, sin = rope_angles(pos)
    q = (rms_norm(cq, g_q) @ w_uq).reshape(B, S, MLA_HEADS, NOPE_DIM + ROPE_DIM)
    q_nope, q_pe = q[..., :NOPE_DIM], q[..., NOPE_DIM:]
    q_pe = apply_rope(q_pe, cos[:, None, :], sin[:, None, :])
    q_lat = jnp.einsum('bshd,chd->bshc', q_nope, w_uk)
    ckv = rms_norm(ckv, g_kv)
    kpe = apply_rope(kpe, cos, sin)
    a, gate = jnp.split(conv_in, 2, axis=-1)
    u = a * jax.nn.sigmoid(gate)
    if ckv_past is None:
        nb = S // Q_BLOCK
        k_chunk = jnp.arange(S) // CHUNK

        def block(args):
            qi, ql, qp = args
            q_chunk = (qi * Q_BLOCK + jnp.arange(Q_BLOCK)) // CHUNK
            mask = k_chunk[None, :] <= q_chunk[:, None]
            return latent_attend(ql, qp, ckv, kpe, mask)

        qlb = q_lat.reshape(B, nb, Q_BLOCK, MLA_HEADS, KV_LORA).swapaxes(0, 1)
        qpb = q_pe.reshape(B, nb, Q_BLOCK, MLA_HEADS, ROPE_DIM).swapaxes(0, 1)
        o_lat = lax.map(block, (jnp.arange(nb), qlb, qpb))
        o_lat = o_lat.swapaxes(0, 1).reshape(B, S, MLA_HEADS, KV_LORA)
        conv_full = jnp.pad(u, ((0, 0), (CONV_STATE, 0), (0, 0)))
    else:
        keys_c = jnp.concatenate([ckv_past, ckv], axis=1)
        keys_r = jnp.concatenate([kpe_past, kpe], axis=1)
        o_lat = latent_attend(q_lat, q_pe, keys_c, keys_r, None)
        conv_full = jnp.concatenate([conv_past, u], axis=1)
    o_mla = jnp.einsum('bshc,chd->bshd', o_lat, w_uv).reshape(B, S, MLA_WIDTH)
    dw = lax.conv_general_dilated(conv_full, w_dw[:, None, :], (1,), 'VALID',
                                  dimension_numbers=('NWC', 'WIO', 'NWC'),
                                  feature_group_count=CONV_CH) + b_dw
    conv_out = jax.nn.silu(layer_norm(dw, g_cn, b_cn))
    mixed = jnp.concatenate([rms_norm(o_mla, g_om), rms_norm(conv_out, g_oc)], axis=-1) @ w_out
    new_conv = conv_full[:, -CONV_STATE:]
    return mixed, ckv, kpe, new_conv


def encoder_layer(x, pos, ckv_past, kpe_past, conv_past, ln_mix, ln_ffn, w_gate, w_up, w_down, mix_params):
    mixed, ckv, kpe, new_conv = token_mixers(rms_norm(x, ln_mix), pos, ckv_past, kpe_past, conv_past, *mix_params)
    h = x + mixed
    f = rms_norm(h, ln_ffn)
    h = h + (jax.nn.silu(f @ w_gate) * (f @ w_up)) @ w_down
    return h, ckv, kpe, new_conv


def setup_inputs(seed: int = 0) -> dict:
    key = jax.random.key(seed)
    ks = jax.random.split(key, 32)
    n = lambda k, shape, s: jax.random.normal(k, shape, jnp.float32) * s
    gain = lambda k, shape: 1.0 + 0.05 * jax.random.normal(k, shape, jnp.float32)
    return {
        "x_prompt": n(ks[0], (BATCH, SEQ, D_MODEL), 1.0),
        "x_sample": n(ks[1], (DEC_BATCH, DEC_SEQ, D_MODEL), 1.0),
        "cache_kv_latent": n(ks[2], (DEPTH, DEC_BATCH, PAST_LEN, KV_LORA), 1.0),
        "cache_k_rope": n(ks[3], (DEPTH, DEC_BATCH, PAST_LEN, ROPE_DIM), 1.0),
        "state_conv": n(ks[4], (DEPTH, DEC_BATCH, CONV_STATE, CONV_CH), 0.5),
        "ln_mix": gain(ks[5], (DEPTH, D_MODEL)),
        "w_in": n(ks[6], (DEPTH, D_MODEL, IN_WIDTH), D_MODEL ** -0.5),
        "g_q": gain(ks[7], (DEPTH, Q_LORA)),
        "w_uq": n(ks[8], (DEPTH, Q_LORA, MLA_HEADS * (NOPE_DIM + ROPE_DIM)), Q_LORA ** -0.5),
        "g_kv": gain(ks[9], (DEPTH, KV_LORA)),
        "w_uk": n(ks[10], (DEPTH, KV_LORA, MLA_HEADS, NOPE_DIM), KV_LORA ** -0.5),
        "w_uv": n(ks[11], (DEPTH, KV_LORA, MLA_HEADS, V_DIM), KV_LORA ** -0.5),
        "w_dw": n(ks[12], (DEPTH, CONV_W, CONV_CH), CONV_W ** -0.5),
        "b_dw": n(ks[13], (DEPTH, CONV_CH), 0.02),
        "g_cn": gain(ks[14], (DEPTH, CONV_CH)),
        "b_cn": n(ks[15], (DEPTH, CONV_CH), 0.02),
        "g_om": gain(ks[16], (DEPTH, MLA_WIDTH)),
        "g_oc": gain(ks[17], (DEPTH, CONV_CH)),
        "w_out": n(ks[18], (DEPTH, MIX_WIDTH, D_MODEL), MIX_WIDTH ** -0.5),
        "ln_ffn": gain(ks[19], (DEPTH, D_MODEL)),
        "w_gate": n(ks[20], (DEPTH, D_MODEL, D_FF), D_MODEL ** -0.5),
        "w_up": n(ks[21], (DEPTH, D_MODEL, D_FF), D_MODEL ** -0.5),
        "w_down": n(ks[22], (DEPTH, D_FF, D_MODEL), D_FF ** -0.5),
        "g_final": gain(ks[23], (D_MODEL,)),
    }


def reference(x_prompt, x_sample, cache_kv_latent, cache_k_rope, state_conv,
              ln_mix, w_in, g_q, w_uq, g_kv, w_uk, w_uv, w_dw, b_dw, g_cn, b_cn, g_om, g_oc,
              w_out, ln_ffn, w_gate, w_up, w_down, g_final):
    past_len = cache_kv_latent.shape[2]
    pos_p = jnp.arange(x_prompt.shape[1])
    pos_s = past_len + jnp.arange(x_sample.shape[1])
    hp, hs = x_prompt, x_sample
    kv_p, kr_p, cv_p, kv_s, kr_s, cv_s = [], [], [], [], [], []
    for l in range(DEPTH):
        mix_params = (w_in[l], g_q[l], w_uq[l], g_kv[l], w_uk[l], w_uv[l], w_dw[l], b_dw[l],
                      g_cn[l], b_cn[l], g_om[l], g_oc[l], w_out[l])
        hp, a, b, c = encoder_layer(hp, pos_p, None, None, None, ln_mix[l], ln_ffn[l],
                                    w_gate[l], w_up[l], w_down[l], mix_params)
        kv_p.append(a); kr_p.append(b); cv_p.append(c)
        hs, a, b, c = encoder_layer(hs, pos_s, cache_kv_latent[l], cache_k_rope[l], state_conv[l],
                                    ln_mix[l], ln_ffn[l], w_gate[l], w_up[l], w_down[l], mix_params)
        kv_s.append(a); kr_s.append(b); cv_s.append(c)
    y_prompt = rms_norm(hp, g_final)
    y_sample = rms_norm(hs, g_final)
    return (y_prompt, y_sample,
            jnp.stack(kv_p), jnp.stack(kr_p), jnp.stack(cv_p),
            jnp.stack(kv_s), jnp.stack(kr_s), jnp.stack(cv_s))
```

```cpp
#include <hip/hip_runtime.h>
#include <math.h>

namespace nv {
constexpr int D = 1024, NB = 8, S = 2048, SB = 16, SS = 16, PAST = 4096;
constexpr int TP = NB * S, TS = SB * SS, T = TP + TS;
constexpr int QL = 384, KVL = 256, RD = 32, CC = 512, INW = 1696, NH = 8, DFF = 2816, CW = 31, CS = 30;
constexpr float EPS = 1e-6f;
constexpr float ATTN_SCALE = 0.10206207261596575f;
constexpr size_t O_Y = 0, O_KVP = (size_t)T * D, O_KRP = O_KVP + (size_t)TP * KVL, O_CVP = O_KRP + (size_t)TP * RD,
                 O_KVS = O_CVP + (size_t)NB * CS * CC, O_KRS = O_KVS + (size_t)TS * KVL, O_CVS = O_KRS + (size_t)TS * RD;

__device__ __forceinline__ float block_sum(float v, float* sm) {
    for (int o = 32; o > 0; o >>= 1) v += __shfl_xor(v, o);
    const int w = threadIdx.x >> 6, nw = blockDim.x >> 6;
    __syncthreads();
    if ((threadIdx.x & 63) == 0) sm[w] = v;
    __syncthreads();
    float r = 0.f;
    for (int i = 0; i < nw; ++i) r += sm[i];
    return r;
}
__device__ __forceinline__ float block_max(float v, float* sm) {
    for (int o = 32; o > 0; o >>= 1) v = fmaxf(v, __shfl_xor(v, o));
    const int w = threadIdx.x >> 6, nw = blockDim.x >> 6;
    __syncthreads();
    if ((threadIdx.x & 63) == 0) sm[w] = v;
    __syncthreads();
    float r = sm[0];
    for (int i = 1; i < nw; ++i) r = fmaxf(r, sm[i]);
    return r;
}

__global__ void __launch_bounds__(256) k_rmsnorm(const float* in, int ldi, const float* g, float* out, int ldo, int n) {
    __shared__ float sm[32];
    const float* x = in + (size_t)blockIdx.x * ldi; float* o = out + (size_t)blockIdx.x * ldo;
    float s = 0.f;
    for (int c = threadIdx.x; c < n; c += 256) { const float v = x[c]; s += v * v; }
    s = block_sum(s, sm);
    const float r = rsqrtf(s / (float)n + EPS);
    for (int c = threadIdx.x; c < n; c += 256) o[c] = x[c] * r * g[c];
}

__global__ void __launch_bounds__(256) k_gemm(const float* A, int lda, const float* Bm, int ldb, float* C, int ldc, const float* R, int ldr, int K) {
    __shared__ float As[32][33], Bs[32][33];
    const int tx = threadIdx.x & 15, ty = threadIdx.x >> 4;
    const int m0 = blockIdx.y * 32, n0 = blockIdx.x * 32;
    float acc[2][2] = {{0.f, 0.f}, {0.f, 0.f}};
    for (int k0 = 0; k0 < K; k0 += 32) {
        for (int i = threadIdx.x; i < 1024; i += 256) { const int r = i >> 5, c = i & 31;
            As[r][c] = A[(size_t)(m0 + r) * lda + k0 + c]; Bs[r][c] = Bm[(size_t)(k0 + r) * ldb + n0 + c]; }
        __syncthreads();
        for (int k = 0; k < 32; ++k) {
            const float a0 = As[ty][k], a1 = As[ty + 16][k], b0 = Bs[k][tx], b1 = Bs[k][tx + 16];
            acc[0][0] += a0 * b0; acc[0][1] += a0 * b1; acc[1][0] += a1 * b0; acc[1][1] += a1 * b1;
        }
        __syncthreads();
    }
    for (int i = 0; i < 2; ++i) for (int j = 0; j < 2; ++j) {
        const int r = m0 + ty + 16 * i, c = n0 + tx + 16 * j; float v = acc[i][j];
        if (R) v += R[(size_t)r * ldr + c];
        C[(size_t)r * ldc + c] = v;
    }
}

__device__ __forceinline__ void rope_cs(int pos, int i, float& c, float& s) {
    const double inv = exp2(-(double)i * 0.8304820237218406);
    const double ang = (double)pos * inv;
    c = (float)cos(ang); s = (float)sin(ang);
}
__device__ __forceinline__ int row_pos(int row) { return row < TP ? (row & (S - 1)) : PAST + ((row - TP) & (SS - 1)); }

__global__ void __launch_bounds__(256) k_postproj(const float* PROJ, const float* g_q, const float* g_kv, float* CQN, float* U, float* out) {
    __shared__ float sm[32];
    const int row = blockIdx.x, t = threadIdx.x;
    const float* p = PROJ + (size_t)row * INW;
    float s = 0.f;
    for (int c = t; c < QL; c += 256) s += p[c] * p[c];
    s = block_sum(s, sm);
    float r = rsqrtf(s / (float)QL + EPS);
    for (int c = t; c < QL; c += 256) CQN[(size_t)row * QL + c] = p[c] * r * g_q[c];
    const float kv = p[QL + t];
    s = block_sum(kv * kv, sm);
    r = rsqrtf(s / (float)KVL + EPS);
    float* okv = row < TP ? out + O_KVP + (size_t)row * KVL : out + O_KVS + (size_t)(row - TP) * KVL;
    okv[t] = kv * r * g_kv[t];
    if (t < 16) {
        float c, sn; rope_cs(row_pos(row), t, c, sn);
        const float x1 = p[QL + KVL + t], x2 = p[QL + KVL + 16 + t];
        float* okr = row < TP ? out + O_KRP + (size_t)row * RD : out + O_KRS + (size_t)(row - TP) * RD;
        okr[t] = x1 * c - x2 * sn; okr[16 + t] = x2 * c + x1 * sn;
    }
    for (int c = t; c < CC; c += 256) {
        const float a = p[QL + KVL + RD + c], g = p[QL + KVL + RD + CC + c];
        const float u = a / (1.f + expf(-g));
        U[(size_t)row * CC + c] = u;
        if (row < TP) { const int b = row >> 11, sidx = row & (S - 1); if (sidx >= S - CS) out[O_CVP + ((size_t)b * CS + (sidx - (S - CS))) * CC + c] = u; }
        else { const int b = (row - TP) >> 4, sidx = (row - TP) & 15; out[O_CVS + ((size_t)b * CS + (CS - SS) + sidx) * CC + c] = u; }
    }
}
__global__ void __launch_bounds__(256) k_cv_state(const float* st, float* out) {
    const int i = blockIdx.x * 256 + threadIdx.x;
    if (i >= SB * (CS - SS) * CC) return;
    const int c = i % CC, r = (i / CC) % (CS - SS), b = i / (CC * (CS - SS));
    out[O_CVS + ((size_t)b * CS + r) * CC + c] = st[((size_t)b * CS + SS + r) * CC + c];
}
__global__ void __launch_bounds__(128) k_rope_q(float* Q) {
    const int row = blockIdx.x, h = threadIdx.x >> 4, i = threadIdx.x & 15;
    float c, s; rope_cs(row_pos(row), i, c, s);
    float* q = Q + (size_t)row * 768 + h * 96 + 64;
    const float x1 = q[i], x2 = q[16 + i];
    q[i] = x1 * c - x2 * s; q[16 + i] = x2 * c + x1 * s;
}

__global__ void __launch_bounds__(256) k_attn(const float* Q, const float* w_uk, const float* w_uv, const float* cache_kv, const float* cache_kr,
                                              const float* out, float* OMLA) {
    __shared__ float qlat[256], qpe[32], pbuf[256], sm[32];
    const int row = blockIdx.x >> 3, h = blockIdx.x & 7, t = threadIdx.x;
    const float* q = Q + (size_t)row * 768 + h * 96;
    { float a = 0.f; for (int d = 0; d < 64; ++d) a += q[d] * w_uk[(size_t)t * 512 + h * 64 + d]; qlat[t] = a; }
    if (t < 32) qpe[t] = q[64 + t];
    __syncthreads();
    int nkeys, b; const float *kc0, *kr0, *kc1, *kr1; int n0;
    if (row < TP) { b = row >> 11; const int sidx = row & (S - 1); nkeys = ((sidx >> 6) + 1) * 64; n0 = nkeys;
        kc0 = out + O_KVP + (size_t)b * S * KVL; kr0 = out + O_KRP + (size_t)b * S * RD; kc1 = kc0; kr1 = kr0; }
    else { b = (row - TP) >> 4; nkeys = PAST + SS; n0 = PAST;
        kc0 = cache_kv + (size_t)b * PAST * KVL; kr0 = cache_kr + (size_t)b * PAST * RD; kc1 = out + O_KVS + (size_t)b * SS * KVL; kr1 = out + O_KRS + (size_t)b * SS * RD; }
    float m = -1e30f, l = 0.f, o = 0.f;
    for (int j0 = 0; j0 < nkeys; j0 += 256) {
        const int j = j0 + t; float sc = -1e30f;
        if (j < nkeys) {
            const float* kc = j < n0 ? kc0 + (size_t)j * KVL : kc1 + (size_t)(j - n0) * KVL;
            const float* kr = j < n0 ? kr0 + (size_t)j * RD : kr1 + (size_t)(j - n0) * RD;
            float a = 0.f;
            for (int c = 0; c < 256; ++c) a += qlat[c] * kc[c];
            for (int r = 0; r < 32; ++r) a += qpe[r] * kr[r];
            sc = a * ATTN_SCALE;
        }
        const float mx = block_max(sc, sm);
        const float mn = fmaxf(m, mx);
        const float alpha = expf(m - mn);
        const float p = (j < nkeys) ? expf(sc - mn) : 0.f;
        __syncthreads();
        pbuf[t] = p;
        const float ps = block_sum(p, sm);
        l = l * alpha + ps; m = mn;
        o *= alpha;
        const int cnt = min(256, nkeys - j0);
        for (int k = 0; k < cnt; ++k) { const int jj = j0 + k;
            const float* kc = jj < n0 ? kc0 + (size_t)jj * KVL : kc1 + (size_t)(jj - n0) * KVL;
            o += pbuf[k] * kc[t]; }
        __syncthreads();
    }
    qlat[t] = o / l;
    __syncthreads();
    if (t < 64) { float a = 0.f; for (int c = 0; c < 256; ++c) a += qlat[c] * w_uv[(size_t)c * 512 + h * 64 + t]; OMLA[(size_t)row * 512 + h * 64 + t] = a; }
}

__global__ void __launch_bounds__(512) k_mix(const float* U, const float* st, const float* OMLA, const float* w_dw, const float* b_dw, const float* g_cn, const float* b_cn,
                                             const float* g_om, const float* g_oc, float* MIX) {
    __shared__ float sm[32];
    const int row = blockIdx.x, c = threadIdx.x;
    float dw = b_dw[c];
    if (row < TP) { const int b = row >> 11, sidx = row & (S - 1);
        for (int j = 0; j < CW; ++j) { const int i = sidx - CS + j; if (i >= 0) dw += U[((size_t)b * S + i) * CC + c] * w_dw[j * CC + c]; } }
    else { const int b = (row - TP) >> 4, sidx = (row - TP) & 15;
        for (int j = 0; j < CW; ++j) { const int i = sidx + j; const float v = i < CS ? st[((size_t)b * CS + i) * CC + c] : U[((size_t)TP + b * SS + (i - CS)) * CC + c]; dw += v * w_dw[j * CC + c]; } }
    const float mu = block_sum(dw, sm) / (float)CC;
    const float xc = dw - mu;
    const float var = block_sum(xc * xc, sm) / (float)CC;
    const float ln = xc * rsqrtf(var + EPS) * g_cn[c] + b_cn[c];
    const float co = ln / (1.f + expf(-ln));
    const float r2 = rsqrtf(block_sum(co * co, sm) / (float)CC + EPS);
    MIX[(size_t)row * 1024 + 512 + c] = co * r2 * g_oc[c];
    const float om = OMLA[(size_t)row * 512 + c];
    const float r1 = rsqrtf(block_sum(om * om, sm) / 512.f + EPS);
    MIX[(size_t)row * 1024 + c] = om * r1 * g_om[c];
}
__global__ void __launch_bounds__(256) k_swiglu(float* G, const float* UP, size_t n) {
    const size_t i = (size_t)blockIdx.x * 256 + threadIdx.x;
    if (i < n) { const float g = G[i]; G[i] = g / (1.f + expf(-g)) * UP[i]; }
}
}

extern "C" void kernel_launch(void* const* d_in, const int* in_sizes, int n_in, void* d_out, int out_size, void* d_ws, size_t ws_size, hipStream_t stream) {
    using namespace nv;
    const float* x_p = (const float*)d_in[0]; const float* x_s = (const float*)d_in[1];
    const float* cache_kv = (const float*)d_in[2]; const float* cache_kr = (const float*)d_in[3]; const float* st = (const float*)d_in[4];
    const float* ln_mix = (const float*)d_in[5]; const float* w_in = (const float*)d_in[6]; const float* g_q = (const float*)d_in[7]; const float* w_uq = (const float*)d_in[8];
    const float* g_kv = (const float*)d_in[9]; const float* w_uk = (const float*)d_in[10]; const float* w_uv = (const float*)d_in[11]; const float* w_dw = (const float*)d_in[12];
    const float* b_dw = (const float*)d_in[13]; const float* g_cn = (const float*)d_in[14]; const float* b_cn = (const float*)d_in[15]; const float* g_om = (const float*)d_in[16];
    const float* g_oc = (const float*)d_in[17]; const float* w_out = (const float*)d_in[18]; const float* ln_ffn = (const float*)d_in[19]; const float* w_gate = (const float*)d_in[20];
    const float* w_up = (const float*)d_in[21]; const float* w_down = (const float*)d_in[22]; const float* g_final = (const float*)d_in[23];
    float* out = (float*)d_out; float* ws = (float*)d_ws;
    float* R0 = ws;
    float* R1 = R0 + (size_t)T * 1024;
    float* CQN = R1 + (size_t)T * INW;
    float* U = CQN + (size_t)T * QL;
    float* XN = R0; float* PROJ = R1; float* Q = R1; float* OMLA = R1 + (size_t)T * 768; float* MIX = R0; float* H = R1; float* F = R0;
    constexpr int CH = 1664;
    float* G = R1 + (size_t)T * 1024; float* UP = G + (size_t)CH * DFF;

    k_rmsnorm<<<TP, 256, 0, stream>>>(x_p, D, ln_mix, XN, D, D);
    k_rmsnorm<<<TS, 256, 0, stream>>>(x_s, D, ln_mix, XN + (size_t)TP * D, D, D);
    k_gemm<<<dim3(INW / 32, T / 32), 256, 0, stream>>>(XN, D, w_in, INW, PROJ, INW, nullptr, 0, D);
    k_postproj<<<T, 256, 0, stream>>>(PROJ, g_q, g_kv, CQN, U, out);
    k_cv_state<<<(SB * (CS - SS) * CC + 255) / 256, 256, 0, stream>>>(st, out);
    k_gemm<<<dim3(768 / 32, T / 32), 256, 0, stream>>>(CQN, QL, w_uq, 768, Q, 768, nullptr, 0, QL);
    k_rope_q<<<T, 128, 0, stream>>>(Q);
    k_attn<<<T * NH, 256, 0, stream>>>(Q, w_uk, w_uv, cache_kv, cache_kr, out, OMLA);
    k_mix<<<T, 512, 0, stream>>>(U, st, OMLA, w_dw, b_dw, g_cn, b_cn, g_om, g_oc, MIX);
    k_gemm<<<dim3(D / 32, TP / 32), 256, 0, stream>>>(MIX, D, w_out, D, H, D, x_p, D, D);
    k_gemm<<<dim3(D / 32, TS / 32), 256, 0, stream>>>(MIX + (size_t)TP * D, D, w_out, D, H + (size_t)TP * D, D, x_s, D, D);
    k_rmsnorm<<<T, 256, 0, stream>>>(H, D, ln_ffn, F, D, D);
    for (int r0 = 0; r0 < T; r0 += CH) {
        k_gemm<<<dim3(DFF / 32, CH / 32), 256, 0, stream>>>(F + (size_t)r0 * D, D, w_gate, DFF, G, DFF, nullptr, 0, D);
        k_gemm<<<dim3(DFF / 32, CH / 32), 256, 0, stream>>>(F + (size_t)r0 * D, D, w_up, DFF, UP, DFF, nullptr, 0, D);
        k_swiglu<<<(unsigned)(((size_t)CH * DFF + 255) / 256), 256, 0, stream>>>(G, UP, (size_t)CH * DFF);
        k_gemm<<<dim3(D / 32, CH / 32), 256, 0, stream>>>(G, DFF, w_down, D, out + O_Y + (size_t)r0 * D, D, H + (size_t)r0 * D, D, DFF);
    }
    k_rmsnorm<<<T, 256, 0, stream>>>(out + O_Y, D, g_final, out + O_Y, D, D);
}
```

```cpp
#include <hip/hip_runtime.h>
#include <hip/hip_bf16.h>
#include <cstdio>
#include <cstdint>
#include <cmath>
#define LAS __attribute__((address_space(3)))
#define GAS __attribute__((address_space(1)))

constexpr int DM = 1024, NBATCH = 8, SEQ = 2048, SBATCH = 16, SSEQ = 16, PAST = 4096;
constexpr int TP = NBATCH * SEQ, TS = SBATCH * SSEQ, T = TP + TS;
constexpr int QL = 384, KVL = 256, RD = 32, CC = 512, INW = 1696, NH = 8, DFF = 2816, CW = 31, CST = 30;
constexpr int N1 = 1792, NQ = 768, NKV = 1024, NGU = 2 * DFF;
constexpr float EPS = 1e-6f;
constexpr float QSCALE = 0.10206207261596575f * 1.4426950408889634f;
constexpr int NPOS = SEQ + SSEQ;
constexpr size_t O_Y = 0, O_KVP = (size_t)T * DM, O_KRP = O_KVP + (size_t)TP * KVL, O_CVP = O_KRP + (size_t)TP * RD,
                 O_KVS = O_CVP + (size_t)NBATCH * CST * CC, O_KRS = O_KVS + (size_t)TS * KVL, O_CVS = O_KRS + (size_t)TS * RD, O_END = O_CVS + (size_t)SBATCH * CST * CC;
__device__ __forceinline__ int posidx(int row) { return row < TP ? (row & (SEQ - 1)) : SEQ + ((row - TP) & (SSEQ - 1)); }

namespace pg8 {
#define PG8_LAS __attribute__((address_space(3)))
typedef unsigned short bf16_t;
typedef short bf16x8 __attribute__((ext_vector_type(8)));
typedef float f32x4 __attribute__((ext_vector_type(4)));
typedef unsigned u32x4 __attribute__((ext_vector_type(4)));
constexpr int BM = 256, BK = 64, HALF = 128, HTB = HALF * BK * 2  , STAGE_BYTES = 8 * HTB, NXCD = 8, WGM = 8;

__host__ __device__ __forceinline__ int lds_byte(int r, int c) { const int st = (r >> 4) * 2 + (c >> 5), rr = r & 15, cc = c & 31, ob = rr * 64 + cc * 2; return st * 1024 + (ob ^ (((ob >> 9) & 1) << 5)); }
__host__ __device__ __forceinline__ void stage_rc(int b, int& R, int& C) { const int st = b / 1024, sb = b % 1024, swz = sb ^ (((sb >> 9) & 1) << 5); R = (st >> 1) * 16 + swz / 64; C = (st & 1) * 32 + (swz % 64) / 2; }
__host__ __device__ __forceinline__ int perm32(int rho) { const int n = rho >> 4, i = rho & 15; return 8 * (i >> 2) + 4 * n + (i & 3); }

struct Unit { int pm, pn; };
struct Gemm { const bf16_t* A; const bf16_t* Bt; int M, N, K; };

struct StaticOrder {
    int nM, nN, nwg, G, c;
    __host__ __device__ void init(int M, int N, int G_, int c_) { nM = M / BM; nN = N / BM; nwg = nM * nN; G = G_; c = c_; }
    __host__ __device__ bool next(int i, Unit& u) const {
        const long L = (long)i * G + c; if (L >= nwg) return false;
        int wgid = (int)L; { const int q = nwg / NXCD, r = nwg % NXCD, xcd = wgid % NXCD, off = wgid / NXCD; wgid = (xcd < r ? xcd * (q + 1) : r * (q + 1) + (xcd - r) * q) + off; }
        const int nig = WGM * nN, gid = wgid / nig, fm = gid * WGM, gsz = (nM - fm) < WGM ? (nM - fm) : WGM;
        u.pm = fm + ((wgid % nig) % gsz); u.pn = (wgid % nig) / gsz; return true;
    }
    __device__ __forceinline__ void a_ready(const Unit&) const {}
    __device__ __forceinline__ void done(const Unit&) const {}
};


__device__ __forceinline__ unsigned cvt_pk_bf16(float lo, float hi) { unsigned r; asm volatile("v_cvt_pk_bf16_f32 %0, %1, %2" : "=v"(r) : "v"(lo), "v"(hi)); return r; }
__device__ __forceinline__ u32x4 pack8(f32x4 a, f32x4 b) { u32x4 w; w.x = cvt_pk_bf16(a[0], a[1]); w.y = cvt_pk_bf16(a[2], a[3]); w.z = cvt_pk_bf16(b[0], b[1]); w.w = cvt_pk_bf16(b[2], b[3]); return w; }
__device__ __forceinline__ float sq4(f32x4 v) { return (v[0] * v[0] + v[1] * v[1]) + (v[2] * v[2] + v[3] * v[3]); }
__device__ __forceinline__ float sigm(float x) { return __builtin_amdgcn_rcpf(1.f + __builtin_amdgcn_exp2f(-1.4426950408889634f * x)); }
__device__ __forceinline__ f32x4 sigm4(f32x4 x) { return (f32x4){sigm(x[0]), sigm(x[1]), sigm(x[2]), sigm(x[3])}; }
__device__ __forceinline__ void rope4(const float* tab, f32x4& x1, f32x4& x2) {
    const f32x4 t0 = *(const f32x4*)tab, t1 = *(const f32x4*)(tab + 4);
    const f32x4 c = {t0[0], t0[2], t1[0], t1[2]}, s = {t0[1], t0[3], t1[1], t1[3]};
    const f32x4 y1 = x1 * c - x2 * s, y2 = x2 * c + x1 * s; x1 = y1; x2 = y2;
}

struct EpiBf16 {
    static constexpr bool PERM = true, AFTER_DRAIN = false;
    bf16_t* O; int ldc; int split_cols; size_t split_stride;
    __device__ __forceinline__ void operator()(const f32x4 (&acc)[2][2][4][2], const Unit& u, int wr, int wc, int fr, int fq) const {
        const int row0 = u.pm * BM + wr * 64 + fr; int colt = u.pn * BM; bf16_t* base = O;
        if (split_cols) { const int t = colt / split_cols; base += (size_t)t * split_stride; colt -= t * split_cols; }
        const int col0 = colt + wc * 32 + 8 * fq;
#pragma unroll
        for (int ai = 0; ai < 2; ++ai)
#pragma unroll
            for (int m = 0; m < 4; ++m) { bf16_t* rowp = base + (size_t)(row0 + ai * HALF + m * 16) * ldc + col0;
#pragma unroll
                for (int bj = 0; bj < 2; ++bj) *(u32x4*)(rowp + bj * HALF) = pack8(acc[ai][bj][m][0], acc[ai][bj][m][1]); }
    }
};

struct EpiProj {
    static constexpr bool PERM = true, AFTER_DRAIN = false;
    bf16_t *CKVN, *CQ, *KPE, *U; float* out; float* ssq_q; const float* g_kv; const float* rope; PG8_LAS float* ex;
    __device__ __forceinline__ void operator()(const f32x4 (&acc)[2][2][4][2], const Unit& u, int wr, int wc, int fr, int fq) const {
        const bool smp = (u.pm == TP / BM);
        const int rl0 = wr * 64 + fr;
        if (u.pn == 0) {
#pragma unroll
            for (int ai = 0; ai < 2; ++ai)
#pragma unroll
                for (int m = 0; m < 4; ++m) { float s = 0.f;
#pragma unroll
                    for (int bj = 0; bj < 2; ++bj) s += sq4(acc[ai][bj][m][0]) + sq4(acc[ai][bj][m][1]);
                    s += __shfl_xor(s, 16); s += __shfl_xor(s, 32);
                    if (fq == 0) ex[(ai * HALF + rl0 + m * 16) * 4 + wc] = s; }
            asm volatile("s_waitcnt lgkmcnt(0)" ::: "memory"); __builtin_amdgcn_s_barrier(); asm volatile("" ::: "memory");
            const int c0 = wc * 32 + 8 * fq;
            f32x4 g[2][2];
#pragma unroll
            for (int bj = 0; bj < 2; ++bj)
#pragma unroll
                for (int n = 0; n < 2; ++n) g[bj][n] = *(const f32x4*)(g_kv + c0 + bj * HALF + 4 * n);
            float* okv = smp ? out + O_KVS : out + O_KVP + (size_t)u.pm * BM * KVL;
#pragma unroll
            for (int ai = 0; ai < 2; ++ai)
#pragma unroll
                for (int m = 0; m < 4; ++m) { const int rl = ai * HALF + rl0 + m * 16; const f32x4 e = *(const PG8_LAS f32x4*)(ex + rl * 4);
                    const float r = rsqrtf(((e[0] + e[1]) + (e[2] + e[3])) * (1.0f / KVL) + EPS);
                    float* of = okv + (size_t)rl * KVL + c0; bf16_t* ob = CKVN + ((size_t)u.pm * BM + rl) * KVL + c0;
#pragma unroll
                    for (int bj = 0; bj < 2; ++bj) { const f32x4 v0 = acc[ai][bj][m][0] * r * g[bj][0], v1 = acc[ai][bj][m][1] * r * g[bj][1];
                        *(f32x4*)(of + bj * HALF) = v0; *(f32x4*)(of + bj * HALF + 4) = v1; *(u32x4*)(ob + bj * HALF) = pack8(v0, v1); } }
        } else if (u.pn <= 2) {
            const int nbj = (u.pn == 1) ? 2 : 1;
            const int cq0 = (u.pn - 1) * BM + wc * 32 + 8 * fq;
#pragma unroll
            for (int ai = 0; ai < 2; ++ai)
#pragma unroll
                for (int m = 0; m < 4; ++m) { const size_t row = (size_t)u.pm * BM + ai * HALF + rl0 + m * 16; float s = 0.f;
#pragma unroll
                    for (int bj = 0; bj < 2; ++bj) if (bj < nbj) { const f32x4 v0 = acc[ai][bj][m][0], v1 = acc[ai][bj][m][1]; s += sq4(v0) + sq4(v1);
                        *(u32x4*)(CQ + row * QL + cq0 + bj * HALF) = pack8(v0, v1); }
                    s += __shfl_xor(s, 16); s += __shfl_xor(s, 32);
                    if (fq == 0) atomicAdd(ssq_q + row, s);
                    if (u.pn == 2 && wc == 0) { f32x4 x1 = acc[ai][1][m][0], x2 = acc[ai][1][m][1];
                        rope4(rope + ((size_t)posidx((int)row) * 16 + 4 * fq) * 2, x1, x2);
                        float* okr = smp ? out + O_KRS + (row - TP) * RD : out + O_KRP + row * RD;
                        *(f32x4*)(okr + 4 * fq) = x1; *(f32x4*)(okr + 16 + 4 * fq) = x2; *(u32x4*)(KPE + row * RD + 8 * fq) = pack8(x1, x2); } }
        } else {
            const int cu = (u.pn - 3) * HALF + wc * 32 + 8 * fq;
            const bool cvp = !smp && ((u.pm & 7) == 7);
#pragma unroll
            for (int ai = 0; ai < 2; ++ai)
#pragma unroll
                for (int m = 0; m < 4; ++m) { const int rl = ai * HALF + rl0 + m * 16; const size_t row = (size_t)u.pm * BM + rl;
                    const f32x4 u0 = acc[ai][0][m][0] * sigm4(acc[ai][1][m][0]), u1 = acc[ai][0][m][1] * sigm4(acc[ai][1][m][1]);
                    *(u32x4*)(U + row * CC + cu) = pack8(u0, u1);
                    if (smp) { const int r = rl, b = r >> 4, s = r & 15; float* o = out + O_CVS + ((size_t)b * CST + (CST - SSEQ) + s) * CC + cu; *(f32x4*)o = u0; *(f32x4*)(o + 4) = u1; }
                    else if (cvp && rl >= BM - CST) { float* o = out + O_CVP + ((size_t)(u.pm >> 3) * CST + (rl - (BM - CST))) * CC + cu; *(f32x4*)o = u0; *(f32x4*)(o + 4) = u1; } }
        }
    }
};

struct EpiQ {
    static constexpr bool PERM = true, AFTER_DRAIN = false;
    bf16_t* Q; const float* ssq_q; const float* rope;
    __device__ __forceinline__ void operator()(const f32x4 (&acc)[2][2][4][2], const Unit& u, int wr, int wc, int fr, int fq) const {
#pragma unroll
        for (int ai = 0; ai < 2; ++ai)
#pragma unroll
            for (int m = 0; m < 4; ++m) { const size_t row = (size_t)u.pm * BM + ai * HALF + wr * 64 + m * 16 + fr;
                const float rq = rsqrtf(ssq_q[row] * (1.0f / QL) + EPS) * QSCALE; const float* tab = rope + (size_t)posidx((int)row) * 32;
#pragma unroll
                for (int bj = 0; bj < 2; ++bj) { const int c0 = u.pn * BM + bj * HALF + wc * 32 + 8 * fq; const int gi = (c0 >> 3) % 12;
                    f32x4 v0 = acc[ai][bj][m][0] * rq, v1 = acc[ai][bj][m][1] * rq;
                    const int g = gi >= 8 ? gi - 8 : 0; f32x4 y1 = v0, y2 = v1; rope4(tab + g * 8, y1, y2);
                    if (gi >= 8) { v0 = y1; v1 = y2; }
                    *(u32x4*)(Q + row * NQ + c0) = pack8(v0, v1); }
                asm volatile("" ::: "memory"); }
    }
};

struct EpiWo {
    static constexpr bool PERM = true, AFTER_DRAIN = false;
    const float* xp; const float* xs; float* Y; bf16_t* HB; float* ssq_h;
    __device__ __forceinline__ void operator()(const f32x4 (&acc)[2][2][4][2], const Unit& u, int wr, int wc, int fr, int fq) const {
        const bool smp = (u.pm == TP / BM);
#pragma unroll
        for (int ai = 0; ai < 2; ++ai)
#pragma unroll
            for (int m = 0; m < 4; ++m) { const size_t row = (size_t)u.pm * BM + ai * HALF + wr * 64 + m * 16 + fr;
                const float* xr = smp ? xs + (row - TP) * DM : xp + row * DM; float s = 0.f;
#pragma unroll
                for (int bj = 0; bj < 2; ++bj) { const int c0 = u.pn * BM + bj * HALF + wc * 32 + 8 * fq;
                    const f32x4 h0 = *(const f32x4*)(xr + c0) + acc[ai][bj][m][0], h1 = *(const f32x4*)(xr + c0 + 4) + acc[ai][bj][m][1];
                    *(f32x4*)(Y + row * DM + c0) = h0; *(f32x4*)(Y + row * DM + c0 + 4) = h1; *(u32x4*)(HB + row * DM + c0) = pack8(h0, h1);
                    s += sq4(h0) + sq4(h1); }
                s += __shfl_xor(s, 16); s += __shfl_xor(s, 32);
                if (fq == 0) atomicAdd(ssq_h + row, s);
                asm volatile("" ::: "memory"); }
    }
};

struct EpiGU {
    static constexpr bool PERM = true, AFTER_DRAIN = false;
    bf16_t* ACT; const float* ssq_h;
    __device__ __forceinline__ void operator()(const f32x4 (&acc)[2][2][4][2], const Unit& u, int wr, int wc, int fr, int fq) const {
        const int c0 = u.pn * HALF + wc * 32 + 8 * fq;
#pragma unroll
        for (int ai = 0; ai < 2; ++ai)
#pragma unroll
            for (int m = 0; m < 4; ++m) { const size_t row = (size_t)u.pm * BM + ai * HALF + wr * 64 + m * 16 + fr;
                const float r = rsqrtf(ssq_h[row] * (1.0f / DM) + EPS);
                const f32x4 g0 = acc[ai][0][m][0] * r, g1 = acc[ai][0][m][1] * r, u0 = acc[ai][1][m][0] * r, u1 = acc[ai][1][m][1] * r;
                *(u32x4*)(ACT + row * DFF + c0) = pack8(g0 * sigm4(g0) * u0, g1 * sigm4(g1) * u1);
                asm volatile("" ::: "memory"); }
    }
};

struct EpiDown {
    static constexpr bool PERM = true, AFTER_DRAIN = false;
    float* Y;
    __device__ __forceinline__ void operator()(const f32x4 (&acc)[2][2][4][2], const Unit& u, int wr, int wc, int fr, int fq) const {
#pragma unroll
        for (int ai = 0; ai < 2; ++ai)
#pragma unroll
            for (int m = 0; m < 4; ++m) { const size_t row = (size_t)u.pm * BM + ai * HALF + wr * 64 + m * 16 + fr;
#pragma unroll
                for (int bj = 0; bj < 2; ++bj) { float* p = Y + row * DM + u.pn * BM + bj * HALF + wc * 32 + 8 * fq;
                    const f32x4 y0 = *(const f32x4*)p + acc[ai][bj][m][0], y1 = *(const f32x4*)(p + 4) + acc[ai][bj][m][1];
                    *(f32x4*)p = y0; *(f32x4*)(p + 4) = y1; }
                asm volatile("" ::: "memory"); }
    }
};

template <class Epi, class Sched, bool ALIGN_EPI = false, bool SP2 = false>
__device__ __forceinline__ void gemm_phase(PG8_LAS unsigned char* lds, const Gemm g, const Sched& S, const Epi& E) {
    int tid_ = threadIdx.x; asm volatile("" : "+v"(tid_));
    const int tid = tid_, wid = __builtin_amdgcn_readfirstlane(tid >> 6), lane = tid & 63, wr = wid >> 2, wc = wid & 3, fr = lane & 15, fq = lane >> 4;
    int K_ = g.K; asm volatile("" : "+s"(K_));
    const int K = K_, nt = K / BK;
    unsigned voffA[2], voffB[2];
#pragma unroll
    for (int i = 0; i < 2; ++i) { int R, C; stage_rc(tid * 16 + i * 8192, R, C); const int Rb = Epi::PERM ? ((R & ~31) + perm32(R & 31)) : R;
        voffA[i] = (unsigned)(R * K + C) * 2u; voffB[i] = (unsigned)(Rb * K + C) * 2u; }
    const size_t kstep = (size_t)(BK * 2);
    const size_t hstep = (size_t)HALF * K * 2;
    const size_t tstep = 2 * hstep;
    const unsigned ldsw = (unsigned)wid * 1024u;
    const int aoff = lds_byte(wr * 64 + fr, fq * 8), boff = lds_byte(wc * 32 + fr, fq * 8);
#define PG8_SA(b, h) (((b) * 2 + (h)) * HTB)
#define PG8_SB(b, h) ((4 + (b) * 2 + (h)) * HTB)
#define PG8_STAGE(bufoff, gbase, voff) do { _Pragma("unroll") for (int _i = 0; _i < 2; ++_i) \
        __builtin_amdgcn_global_load_lds((const unsigned*)((const char*)(gbase) + (voff)[_i]), (PG8_LAS unsigned*)(lds + (bufoff) + ldsw + _i * 8192), 16, 0, 0); } while (0)
#define PG8_LDA(dst, b, h) do { _Pragma("unroll") for (int m = 0; m < 4; ++m) _Pragma("unroll") for (int k = 0; k < 2; ++k) dst[m][k] = *(const PG8_LAS bf16x8*)(lds + PG8_SA(b, h) + aoff + m * 2048 + k * 1024); } while (0)
#define PG8_LDB(dst, b, h) do { _Pragma("unroll") for (int n = 0; n < 2; ++n) _Pragma("unroll") for (int k = 0; k < 2; ++k) dst[n][k] = *(const PG8_LAS bf16x8*)(lds + PG8_SB(b, h) + boff + n * 2048 + k * 1024); } while (0)
#define PG8_MMA(ai, bj, At, Bt) do { __builtin_amdgcn_s_setprio(1); _Pragma("unroll") for (int m = 0; m < 4; ++m) _Pragma("unroll") for (int n = 0; n < 2; ++n) _Pragma("unroll") for (int k = 0; k < 2; ++k) \
        acc[ai][bj][m][n] = __builtin_amdgcn_mfma_f32_16x16x32_bf16(Bt[n][k], At[m][k], acc[ai][bj][m][n], 0, 0, 0); __builtin_amdgcn_s_setprio(0); } while (0)
#define PG8_WAIT_V(n) asm volatile("s_waitcnt vmcnt(" #n ")" ::: "memory")
#define PG8_WAIT_L(n) asm volatile("s_waitcnt lgkmcnt(" #n ")" ::: "memory")
#define PG8_BAR __builtin_amdgcn_s_barrier()
#define PG8_SCHED __builtin_amdgcn_sched_barrier(0)
    Unit cur, nxt; int ui = 0;
    if (!S.next(0, cur)) return;
    f32x4 acc[2][2][4][2];
#pragma unroll
    for (int a = 0; a < 2; ++a)
#pragma unroll
        for (int b = 0; b < 2; ++b)
#pragma unroll
            for (int m = 0; m < 4; ++m)
#pragma unroll
                for (int n = 0; n < 2; ++n) acc[a][b][m][n] = (f32x4){0.f, 0.f, 0.f, 0.f};
    bf16x8 At[4][2], B0[2][2], B1[2][2];
    const char* cA = (const char*)g.A + (size_t)cur.pm * tstep; const char* cB = (const char*)g.Bt + (size_t)cur.pn * tstep;
    S.a_ready(cur);
    if constexpr (SP2) {
        PG8_STAGE(PG8_SB(0, 0), cB, voffB); PG8_STAGE(PG8_SB(0, 1), cB + hstep, voffB); PG8_STAGE(PG8_SA(0, 0), cA, voffA); PG8_STAGE(PG8_SA(0, 1), cA + hstep, voffA);
        if (wr == 1) PG8_BAR;
        PG8_WAIT_V(2); PG8_BAR;
        PG8_STAGE(PG8_SB(1, 0), cB + kstep, voffB); PG8_STAGE(PG8_SA(1, 0), cA + kstep, voffA); PG8_STAGE(PG8_SB(1, 1), cB + hstep + kstep, voffB);
        PG8_WAIT_V(6); PG8_BAR;
    } else {
        PG8_STAGE(PG8_SB(0, 0), cB, voffB); PG8_STAGE(PG8_SA(0, 0), cA, voffA); PG8_STAGE(PG8_SB(0, 1), cB + hstep, voffB); PG8_STAGE(PG8_SA(0, 1), cA + hstep, voffA);
        if (wr == 1) PG8_BAR;
        PG8_WAIT_V(4); PG8_BAR;
        PG8_STAGE(PG8_SB(1, 0), cB + kstep, voffB); PG8_STAGE(PG8_SA(1, 0), cA + kstep, voffA); PG8_STAGE(PG8_SB(1, 1), cB + hstep + kstep, voffB);
        PG8_WAIT_V(6); PG8_BAR;
    }
    for (;;) {
        const bool has_next = S.next(ui + 1, nxt);
        const char* nA = has_next ? (const char*)g.A + (size_t)nxt.pm * tstep : cA; const char* nB = has_next ? (const char*)g.Bt + (size_t)nxt.pn * tstep : cB;
        for (int t = 0; t < nt; t += 2) {
            const bool last = (t == nt - 2);
            const char* a1 = cA + (size_t)(t + 1) * kstep;
            const char* a2 = last ? nA : cA + (size_t)(t + 2) * kstep; const char* b2 = last ? nB : cB + (size_t)(t + 2) * kstep;
            const char* a3 = a2 + kstep; const char* b3 = b2 + kstep;
            if (last && has_next) S.a_ready(nxt);
            if constexpr (SP2) {
            PG8_LDB(B0, 0, 0); PG8_LDB(B1, 0, 1); PG8_SCHED; PG8_LDA(At, 0, 0); PG8_STAGE(PG8_SA(1, 1), a1 + hstep, voffA);
            PG8_WAIT_V(8); PG8_WAIT_L(0); PG8_BAR; PG8_MMA(0, 0, At, B0); PG8_MMA(0, 1, At, B1); PG8_BAR; PG8_SCHED;
            PG8_LDA(At, 0, 1); PG8_STAGE(PG8_SB(0, 0), b2, voffB); PG8_STAGE(PG8_SB(0, 1), b2 + hstep, voffB); PG8_STAGE(PG8_SA(0, 0), a2, voffA);
            PG8_WAIT_V(8); PG8_WAIT_L(0); PG8_BAR; PG8_MMA(1, 0, At, B0); PG8_MMA(1, 1, At, B1); PG8_BAR; PG8_SCHED;
            PG8_LDB(B0, 1, 0); PG8_LDB(B1, 1, 1); PG8_SCHED; PG8_LDA(At, 1, 0); PG8_STAGE(PG8_SA(0, 1), a2 + hstep, voffA);
            PG8_WAIT_V(8); PG8_WAIT_L(0); PG8_BAR; PG8_MMA(0, 0, At, B0); PG8_MMA(0, 1, At, B1); PG8_BAR; PG8_SCHED;
            PG8_LDA(At, 1, 1); PG8_STAGE(PG8_SB(1, 0), b3, voffB); PG8_STAGE(PG8_SB(1, 1), b3 + hstep, voffB); PG8_STAGE(PG8_SA(1, 0), a3, voffA);
            PG8_WAIT_V(8); PG8_WAIT_L(0); PG8_BAR; PG8_MMA(1, 0, At, B0); PG8_MMA(1, 1, At, B1); PG8_BAR; PG8_SCHED;
            } else {
            PG8_LDB(B0, 0, 0); PG8_SCHED; PG8_LDA(At, 0, 0); PG8_STAGE(PG8_SA(1, 1), a1 + hstep, voffA);
            PG8_WAIT_L(8); PG8_BAR; PG8_WAIT_L(0); PG8_MMA(0, 0, At, B0); PG8_BAR; PG8_SCHED;
            PG8_LDB(B1, 0, 1); PG8_STAGE(PG8_SB(0, 0), b2, voffB);
            PG8_BAR; PG8_WAIT_L(0); PG8_MMA(0, 1, At, B1); PG8_BAR;
            PG8_LDA(At, 0, 1); PG8_STAGE(PG8_SA(0, 0), a2, voffA);
            PG8_BAR; PG8_WAIT_L(0); PG8_MMA(1, 0, At, B0); PG8_BAR; PG8_SCHED;
            PG8_STAGE(PG8_SB(0, 1), b2 + hstep, voffB);
            PG8_WAIT_V(6); PG8_BAR; PG8_MMA(1, 1, At, B1); PG8_BAR;
            PG8_LDB(B0, 1, 0); PG8_SCHED; PG8_LDA(At, 1, 0); PG8_STAGE(PG8_SA(0, 1), a2 + hstep, voffA);
            PG8_WAIT_L(8); PG8_BAR; PG8_WAIT_L(0); PG8_MMA(0, 0, At, B0); PG8_BAR; PG8_SCHED;
            PG8_LDB(B1, 1, 1); PG8_STAGE(PG8_SB(1, 0), b3, voffB);
            PG8_BAR; PG8_WAIT_L(0); PG8_MMA(0, 1, At, B1); PG8_BAR;
            PG8_LDA(At, 1, 1); PG8_STAGE(PG8_SA(1, 0), a3, voffA);
            PG8_BAR; PG8_WAIT_L(0); PG8_MMA(1, 0, At, B0); PG8_BAR; PG8_SCHED;
            PG8_STAGE(PG8_SB(1, 1), b3 + hstep, voffB);
            PG8_WAIT_V(6); PG8_BAR; PG8_MMA(1, 1, At, B1); PG8_BAR;
            }
        }
        if constexpr (ALIGN_EPI) { if (wr == 0) PG8_BAR; }
        if constexpr (!Epi::AFTER_DRAIN) { int t2 = tid; asm volatile("" : "+v"(t2)); const int fr2 = t2 & 15, fq2 = (t2 >> 4) & 3;
            E(acc, cur, wr, wc, fr2, fq2); S.done(cur); }
        if (!has_next) break;
#pragma unroll
        for (int a = 0; a < 2; ++a)
#pragma unroll
            for (int b = 0; b < 2; ++b)
#pragma unroll
                for (int m = 0; m < 4; ++m)
#pragma unroll
                    for (int n = 0; n < 2; ++n) acc[a][b][m][n] = (f32x4){0.f, 0.f, 0.f, 0.f};
        cur = nxt; cA = nA; cB = nB; ++ui;
        if constexpr (ALIGN_EPI) { if (wr == 1) PG8_BAR; }
    }
    PG8_WAIT_V(0);
    if constexpr (!ALIGN_EPI) { if (wr == 0) PG8_BAR; }
    PG8_BAR;
    if constexpr (Epi::AFTER_DRAIN) { E.fused(acc, cur, wr, wc, fr, fq, lds, wid, lane); S.done(cur); }
#undef PG8_SA
#undef PG8_SB
#undef PG8_STAGE
#undef PG8_LDA
#undef PG8_LDB
#undef PG8_MMA
#undef PG8_WAIT_V
#undef PG8_WAIT_L
#undef PG8_BAR
#undef PG8_SCHED
}
}
namespace att {
using bf16x8 = __attribute__((ext_vector_type(8))) short;
using s16x4 = __attribute__((ext_vector_type(4))) short;
using f32x16 = __attribute__((ext_vector_type(16))) float;
using f32x4 = __attribute__((ext_vector_type(4))) float;
using u32x4 = __attribute__((ext_vector_type(4))) unsigned;
using u32x2 = __attribute__((ext_vector_type(2))) unsigned;
typedef unsigned short bf16;
typedef LAS char* lptr;
typedef short v4i16_t __attribute__((ext_vector_type(4)));
#define SBAR() __builtin_amdgcn_sched_barrier(0)
__device__ __forceinline__ int crow(int r, int hi) { return (r & 3) + 8 * (r >> 2) + 4 * hi; }
__device__ __forceinline__ void glds16(const void* gsrc, unsigned lds_dst) { unsigned keep;
    asm volatile("s_mov_b32 %0, m0\n\ts_mov_b32 m0, %2\n\ts_nop 0\n\tglobal_load_lds_dwordx4 %1, off\n\ts_mov_b32 m0, %0" : "=&s"(keep) : "v"(gsrc), "s"(lds_dst) : "memory"); }
__device__ __forceinline__ float max3f(float a, float b, float c) { float r; asm("v_max3_f32 %0, %1, %2, %3" : "=v"(r) : "v"(a), "v"(b), "v"(c)); return r; }
__device__ __forceinline__ float max2f(float a, float b) { float r; asm("v_max_f32_e32 %0, %1, %2" : "=v"(r) : "v"(a), "v"(b)); return r; }
typedef float f32x2_t __attribute__((ext_vector_type(2))); typedef __bf16 bf16x2_t __attribute__((ext_vector_type(2)));
__device__ __forceinline__ unsigned cvtpk_s(float lo, float hi) { f32x2_t v = {lo, hi}; bf16x2_t b = __builtin_convertvector(v, bf16x2_t); return __builtin_bit_cast(unsigned, b); }
__device__ __forceinline__ unsigned short f2bf(float f) { unsigned u = __builtin_bit_cast(unsigned, f); return (unsigned short)((u + 0x7fffu + ((u >> 16) & 1u)) >> 16); }
__device__ __forceinline__ float wave_sum(float v) {
#pragma unroll
    for (int o = 1; o < 64; o <<= 1) v += __shfl_xor(v, o);
    return v;
}
#define WAIT_ALL_BAR() asm volatile("s_waitcnt vmcnt(0) lgkmcnt(0)\n\ts_barrier" ::: "memory")

constexpr int KSLOT = 12288, VSLOT = 8192;
constexpr int L_K = 0, L_V = 2 * KSLOT, L_WS = L_V + 2 * VSLOT, L_OST = L_WS + 8 * 256, L_END = L_OST + 8 * 4096;

__device__ __forceinline__ void qkt6(f32x16& p0, f32x16& p1, const char* Kslot, const bf16x8* qr, int r32, int hi) {
    const char* kb = Kslot + hi * 1024 + r32 * 16;
    const f32x16 z = f32x16{};
#pragma unroll
    for (int d0 = 0; d0 < 6; ++d0) {
        const bf16x8 b0 = *reinterpret_cast<const bf16x8*>(kb + d0 * 2048);
        const bf16x8 b1 = *reinterpret_cast<const bf16x8*>(kb + d0 * 2048 + 512);
        if (d0 == 0) { p0 = __builtin_amdgcn_mfma_f32_32x32x16_bf16(b0, qr[0], z, 0, 0, 0); p1 = __builtin_amdgcn_mfma_f32_32x32x16_bf16(b1, qr[0], z, 0, 0, 0); }
        else { p0 = __builtin_amdgcn_mfma_f32_32x32x16_bf16(b0, qr[d0], p0, 0, 0, 0); p1 = __builtin_amdgcn_mfma_f32_32x32x16_bf16(b1, qr[d0], p1, 0, 0, 0); } }
}
__device__ __forceinline__ float rowmax(const f32x16& p0, const f32x16& p1) {
    float a = max3f(p0[0], p0[1], p1[0]), b = max3f(p0[2], p0[3], p1[1]); a = max3f(a, p1[2], p1[3]);
#pragma unroll
    for (int r = 4; r < 16; r += 4) { a = max3f(a, p0[r], p0[r + 1]); b = max3f(b, p0[r + 2], p0[r + 3]); a = max3f(a, p1[r], p1[r + 1]); b = max3f(b, p1[r + 2], p1[r + 3]); }
    const float m = max2f(a, b);
    auto rr = __builtin_amdgcn_permlane32_swap(__float_as_uint(m), __float_as_uint(m), false, false);
    return max2f(__uint_as_float(rr[0]), __uint_as_float(rr[1]));
}
__device__ __forceinline__ void pv(f32x16* o, int vb, bf16x8 pa0, bf16x8 pa1, bf16x8 pa2, bf16x8 pa3) {
#pragma unroll
    for (int d0 = 0; d0 < 2; ++d0) { s16x4 lo[4], hi[4];
#pragma unroll
        for (int ks = 0; ks < 4; ++ks) {
            asm volatile("ds_read_b64_tr_b16 %0,%1 offset:%c2" : "=&v"(lo[ks]) : "v"(vb), "i"(d0 * 4096 + ks * 1024) : "memory");
            asm volatile("ds_read_b64_tr_b16 %0,%1 offset:%c2" : "=&v"(hi[ks]) : "v"(vb), "i"(d0 * 4096 + ks * 1024 + 512) : "memory"); }
        asm volatile("s_waitcnt lgkmcnt(0)" ::: "memory"); SBAR();
#define PK(k) (bf16x8){lo[k][0], lo[k][1], lo[k][2], lo[k][3], hi[k][0], hi[k][1], hi[k][2], hi[k][3]}
        o[d0] = __builtin_amdgcn_mfma_f32_32x32x16_bf16(pa0, PK(0), o[d0], 0, 0, 0);
        o[d0] = __builtin_amdgcn_mfma_f32_32x32x16_bf16(pa1, PK(1), o[d0], 0, 0, 0);
        o[d0] = __builtin_amdgcn_mfma_f32_32x32x16_bf16(pa2, PK(2), o[d0], 0, 0, 0);
        o[d0] = __builtin_amdgcn_mfma_f32_32x32x16_bf16(pa3, PK(3), o[d0], 0, 0, 0);
#undef PK
    }
}

__device__ __forceinline__ void prompt_unit(int b, int h, int qb, const bf16* Q, const bf16* __restrict__ KN, const bf16* __restrict__ KPE, const bf16* __restrict__ V, bf16* O, char* shm) {
    int tid_ = threadIdx.x; asm volatile("" : "+v"(tid_)); const int tid = tid_, lane = tid & 63, r32 = lane & 31, hi = lane >> 5; const int wid = __builtin_amdgcn_readfirstlane(tid >> 6);
    const long rowbase = (long)b * SEQ; const int q0 = qb * 256;
    const bf16* Qw = Q + (rowbase + q0 + wid * 32) * NQ + h * 96;
    const unsigned lds0 = (unsigned)(uintptr_t)shm;
    float* wsf = (float*)(shm + L_WS) + wid * 64;
    const bf16* ksrc = KN + (rowbase + lane) * 512 + h * 64 + wid * 8;
    const bf16* psrc = KPE + (rowbase + lane) * RD + (wid & 3) * 8;
    const bf16* vsrc = V + (rowbase + 16 * (wid & 3) + (lane >> 2)) * 512 + h * 64 + (wid >> 2) * 32 + (lane & 3) * 8;
    const unsigned kdst = lds0 + L_K + wid * 1024, pdst = lds0 + L_K + (8 + (wid & 3)) * 1024, vdst = lds0 + L_V + wid * 1024;
#define DMA_KV(t, sl) do { glds16(ksrc + (long)(t) * 64 * 512, (unsigned)__builtin_amdgcn_readfirstlane(kdst + (sl) * KSLOT)); \
        if (wid < 4) glds16(psrc + (long)(t) * 64 * RD, (unsigned)__builtin_amdgcn_readfirstlane(pdst + (sl) * KSLOT)); \
        glds16(vsrc + (long)(t) * 64 * 512, (unsigned)__builtin_amdgcn_readfirstlane(vdst + (sl) * VSLOT)); } while (0)
    const int vb0 = (int)(lds0 + L_V) + ((lane >> 4) & 1) * 32 + (lane & 3) * 8 + (4 * hi + ((lane & 15) >> 2)) * 64;
    const char* Kbase = shm + L_K;
    const int NT = 4 * qb + 4, nvis = 4 * qb + (wid >> 1) + 1;
    DMA_KV(0, 0);
    bf16x8 qr[6];
#pragma unroll
    for (int d0 = 0; d0 < 6; ++d0) qr[d0] = *reinterpret_cast<const bf16x8*>(&Qw[(long)r32 * NQ + d0 * 16 + hi * 8]);
    float m = -1e30f, l = 0.f; f32x16 o[2]; o[0] = f32x16{}; o[1] = f32x16{};
    WAIT_ALL_BAR();
    for (int t = 0; t < NT; ++t) {
        const int cur = t & 1;
        if (t + 1 < NT) DMA_KV(t + 1, cur ^ 1);
        if (t < nvis) {
            f32x16 p0, p1;
            qkt6(p0, p1, Kbase + cur * KSLOT, qr, r32, hi);
            const float rm = rowmax(p0, p1);
            const float mn = __builtin_fmaxf(m, rm); const float f = __builtin_amdgcn_exp2f(m - mn); m = mn;
            float sacc = 0.f;
#pragma unroll
            for (int r = 0; r < 16; ++r) { p0[r] = __builtin_amdgcn_exp2f(p0[r] - mn); p1[r] = __builtin_amdgcn_exp2f(p1[r] - mn); sacc += p0[r] + p1[r]; }
            l = l * f + sacc;
            if (__any(f != 1.0f)) {
                if (hi == 0) wsf[r32] = f;
                asm volatile("s_waitcnt lgkmcnt(0)" ::: "memory");
#pragma unroll
                for (int r = 0; r < 16; ++r) { const float fr_ = wsf[crow(r, hi)]; o[0][r] *= fr_; o[1][r] *= fr_; }
            }
            u32x4 pw0 = {cvtpk_s(p0[0], p0[1]), cvtpk_s(p0[2], p0[3]), cvtpk_s(p0[4], p0[5]), cvtpk_s(p0[6], p0[7])};
            u32x4 pw1 = {cvtpk_s(p0[8], p0[9]), cvtpk_s(p0[10], p0[11]), cvtpk_s(p0[12], p0[13]), cvtpk_s(p0[14], p0[15])};
            u32x4 pw2 = {cvtpk_s(p1[0], p1[1]), cvtpk_s(p1[2], p1[3]), cvtpk_s(p1[4], p1[5]), cvtpk_s(p1[6], p1[7])};
            u32x4 pw3 = {cvtpk_s(p1[8], p1[9]), cvtpk_s(p1[10], p1[11]), cvtpk_s(p1[12], p1[13]), cvtpk_s(p1[14], p1[15])};
            pv(o, vb0 + cur * VSLOT, __builtin_bit_cast(bf16x8, pw0), __builtin_bit_cast(bf16x8, pw1), __builtin_bit_cast(bf16x8, pw2), __builtin_bit_cast(bf16x8, pw3));
        }
        WAIT_ALL_BAR();
    }
    { auto rr = __builtin_amdgcn_permlane32_swap(__float_as_uint(l), __float_as_uint(l), false, false); l = __uint_as_float(rr[0]) + __uint_as_float(rr[1]); }
    if (hi == 0) wsf[32 + r32] = l;
    asm volatile("s_waitcnt lgkmcnt(0)" ::: "memory");
    float rli[16];
#pragma unroll
    for (int r = 0; r < 16; ++r) rli[r] = __builtin_amdgcn_rcpf(wsf[32 + crow(r, hi)]);
    bf16* Ow = O + (rowbase + q0 + wid * 32) * 512 + h * 64;
    { bf16* stg = (bf16*)(shm + L_OST) + wid * 2048;
#pragma unroll
        for (int r = 0; r < 16; ++r) { const int orow = crow(r, hi);
#pragma unroll
            for (int d0 = 0; d0 < 2; ++d0) stg[orow * 64 + d0 * 32 + r32] = f2bf(o[d0][r] * rli[r]); }
        asm volatile("s_waitcnt lgkmcnt(0)" ::: "memory");
#pragma unroll
        for (int i = 0; i < 4; ++i) { const int row = i * 8 + (lane >> 3), ch = lane & 7; const u32x4 v = *(const u32x4*)(stg + row * 64 + ch * 8); *(u32x4*)(Ow + (long)row * 512 + ch * 8) = v; } }
    asm volatile("s_waitcnt lgkmcnt(0)\n\ts_barrier" ::: "memory");
#undef DMA_KV
}

constexpr int DQS = 592, D_QL = 0, D_KT = 128 * DQS, D_END = D_KT + 64 * DQS;
__device__ __forceinline__ void decode_unit(int b, int sp, const bf16* Q, const bf16* __restrict__ WUKn, const float* __restrict__ cache_kv, const float* __restrict__ cache_kr,
                                            const bf16* __restrict__ CKVN, const bf16* __restrict__ KPE, float* PART, float* ML, lptr shm) {
    int tid_ = threadIdx.x; asm volatile("" : "+v"(tid_)); const int tid = tid_, lane = tid & 63, fr = lane & 15, g = lane >> 4; const int w = __builtin_amdgcn_readfirstlane(tid >> 6);
    const lptr QLp = shm + D_QL, KTp = shm + D_KT;
    const float* kc = cache_kv + ((size_t)b * PAST + (size_t)sp * 256) * KVL; const float* kr = cache_kr + ((size_t)b * PAST + (size_t)sp * 256) * RD;
    f32x4 pre[9];
#define DEC_LOAD(t) do { const float* kc_ = kc + (size_t)(t) * 64 * KVL + tid * 4; _Pragma("unroll") for (int i_ = 0; i_ < 8; ++i_) pre[i_] = *(const f32x4*)(kc_ + i_ * 2048); \
        pre[8] = *(const f32x4*)(kr + (size_t)(t) * 64 * RD + tid * 4); } while (0)
#define DEC_STORE() do { _Pragma("unroll") for (int i_ = 0; i_ < 8; ++i_) { u32x2 w_; w_.x = cvtpk_s(pre[i_][0], pre[i_][1]); w_.y = cvtpk_s(pre[i_][2], pre[i_][3]); \
            *(LAS u32x2*)(KTp + ((tid >> 6) + 8 * i_) * DQS + (tid & 63) * 8) = w_; } \
        { const int a_ = tid & 7; u32x2 w_; w_.x = cvtpk_s(pre[8][0], pre[8][1]); w_.y = cvtpk_s(pre[8][2], pre[8][3]); \
            *(LAS u32x2*)(KTp + (tid >> 3) * DQS + 512 + 16 * (a_ & 3) + 8 * (a_ >> 2)) = w_; } } while (0)
    DEC_LOAD(0);
    __syncthreads();
    const bf16* qrow = Q + ((size_t)TP + b * SSEQ + fr) * NQ + w * 96;
    *(LAS u32x4*)(QLp + (16 * w + fr) * DQS + 512 + 16 * g) = *(const u32x4*)(qrow + 64 + 8 * g);
    { const bf16x8 qf0 = *(const bf16x8*)(qrow + 8 * g), qf1 = *(const bf16x8*)(qrow + 32 + 8 * g);
#pragma unroll 4
        for (int cb = 0; cb < 16; ++cb) { const bf16* wr_ = WUKn + (size_t)(16 * cb + fr) * 512 + w * 64 + 8 * g;
            f32x4 a = {0.f, 0.f, 0.f, 0.f};
            a = __builtin_amdgcn_mfma_f32_16x16x32_bf16(*(const bf16x8*)wr_, qf0, a, 0, 0, 0);
            a = __builtin_amdgcn_mfma_f32_16x16x32_bf16(*(const bf16x8*)(wr_ + 32), qf1, a, 0, 0, 0);
            u32x2 w_; w_.x = cvtpk_s(a[0], a[1]); w_.y = cvtpk_s(a[2], a[3]);
            *(LAS u32x2*)(QLp + (16 * w + fr) * DQS + (16 * cb + 4 * g) * 2) = w_; } }
    DEC_STORE();
    __syncthreads();
    const int NT = 4 + (sp == 15 ? 1 : 0);
    float m = -1e30f, l = 0.f; f32x4 o[16];
#pragma unroll
    for (int cb = 0; cb < 16; ++cb) o[cb] = (f32x4){0.f, 0.f, 0.f, 0.f};
    for (int t = 0; t < NT; ++t) {
        if (t + 1 < 4) DEC_LOAD(t + 1);
        f32x4 s[4];
#pragma unroll
        for (int kb = 0; kb < 4; ++kb) s[kb] = (f32x4){0.f, 0.f, 0.f, 0.f};
#pragma unroll
        for (int ds = 0; ds < 9; ++ds) { const bf16x8 qf = *(const LAS bf16x8*)(QLp + (16 * w + fr) * DQS + (32 * ds + 8 * g) * 2);
#pragma unroll
            for (int kb = 0; kb < 4; ++kb) { const bf16x8 kf = *(const LAS bf16x8*)(KTp + (16 * kb + fr) * DQS + (32 * ds + 8 * g) * 2);
                s[kb] = __builtin_amdgcn_mfma_f32_16x16x32_bf16(kf, qf, s[kb], 0, 0, 0); } }
        if (t == 4) { s[1] = (f32x4){-1e30f, -1e30f, -1e30f, -1e30f}; s[2] = s[1]; s[3] = s[1]; }
        float rm = __builtin_fmaxf(__builtin_fmaxf(s[0][0], s[0][1]), __builtin_fmaxf(s[0][2], s[0][3]));
#pragma unroll
        for (int kb = 1; kb < 4; ++kb) rm = __builtin_fmaxf(rm, __builtin_fmaxf(__builtin_fmaxf(s[kb][0], s[kb][1]), __builtin_fmaxf(s[kb][2], s[kb][3])));
        rm = __builtin_fmaxf(rm, __shfl_xor(rm, 16)); rm = __builtin_fmaxf(rm, __shfl_xor(rm, 32));
        const float mn = __builtin_fmaxf(m, rm), f = __builtin_amdgcn_exp2f(m - mn); m = mn;
        float ls = 0.f;
#pragma unroll
        for (int kb = 0; kb < 4; ++kb)
#pragma unroll
            for (int i = 0; i < 4; ++i) { s[kb][i] = __builtin_amdgcn_exp2f(s[kb][i] - mn); ls += s[kb][i]; }
        l = l * f + ls;
#pragma unroll
        for (int cb = 0; cb < 16; ++cb) o[cb] *= f;
        u32x4 pw[2];
#pragma unroll
        for (int s2 = 0; s2 < 2; ++s2) pw[s2] = (u32x4){cvtpk_s(s[2 * s2][0], s[2 * s2][1]), cvtpk_s(s[2 * s2][2], s[2 * s2][3]), cvtpk_s(s[2 * s2 + 1][0], s[2 * s2 + 1][1]), cvtpk_s(s[2 * s2 + 1][2], s[2 * s2 + 1][3])};
#pragma unroll
        for (int cb = 0; cb < 16; ++cb)
#pragma unroll
            for (int s2 = 0; s2 < 2; ++s2) { const lptr va = KTp + (32 * s2 + 4 * g + (fr >> 2)) * DQS + (16 * cb + 4 * (fr & 3)) * 2;
                const s16x4 lo = __builtin_bit_cast(s16x4, __builtin_amdgcn_ds_read_tr16_b64_v4i16((LAS v4i16_t*)va));
                const s16x4 hh = __builtin_bit_cast(s16x4, __builtin_amdgcn_ds_read_tr16_b64_v4i16((LAS v4i16_t*)(va + 16 * DQS)));
                const bf16x8 vf = {lo[0], lo[1], lo[2], lo[3], hh[0], hh[1], hh[2], hh[3]};
                o[cb] = __builtin_amdgcn_mfma_f32_16x16x32_bf16(vf, __builtin_bit_cast(bf16x8, pw[s2]), o[cb], 0, 0, 0); }
        __syncthreads();
        if (t + 1 < NT) {
            if (t + 1 < 4) { DEC_STORE(); }
            else {
                for (int idx = tid; idx < 16 * 36; idx += 512) { const int key = idx / 36, ch = idx - key * 36; const size_t row = (size_t)TP + b * SSEQ + key;
                    const u32x4 v = (ch < 32) ? *(const u32x4*)(CKVN + row * KVL + ch * 8) : *(const u32x4*)(KPE + row * RD + (ch - 32) * 8);
                    *(LAS u32x4*)(KTp + key * DQS + ch * 16) = v; }
                for (int idx = tid; idx < 48 * 37; idx += 512) { const int key = 16 + idx / 37, ch = idx % 37; *(LAS u32x4*)(KTp + key * DQS + ch * 16) = (u32x4){0u, 0u, 0u, 0u}; }
            }
        }
        __syncthreads();
    }
    l += __shfl_xor(l, 16); l += __shfl_xor(l, 32);
    const size_t prow = ((size_t)(b * 16 + sp) * 128 + 16 * w + fr);
#pragma unroll
    for (int cb = 0; cb < 16; ++cb) *(f32x4*)(PART + prow * 256 + 16 * cb + 4 * g) = o[cb];
    if (g == 0) { ML[prow * 2] = m; ML[prow * 2 + 1] = l; }
#undef DEC_LOAD
#undef DEC_STORE
}

__device__ __forceinline__ void combine_item(int b, int tok, const float* PART, const float* ML, const bf16* __restrict__ Wkv_t, bf16* OMLA, lptr shm) {
    int tid_ = threadIdx.x; asm volatile("" : "+v"(tid_)); const int tid = tid_, lane = tid & 63; const int h = __builtin_amdgcn_readfirstlane(tid >> 6);
    LAS float* OL = (LAS float*)shm;
    float mv[16], lv[16], M = -1e30f;
#pragma unroll
    for (int s = 0; s < 16; ++s) { const size_t pr = ((size_t)(b * 16 + s) * 128 + 16 * h + tok); mv[s] = ML[pr * 2]; lv[s] = ML[pr * 2 + 1]; M = __builtin_fmaxf(M, mv[s]); }
    f32x4 acc = {0.f, 0.f, 0.f, 0.f}; float L = 0.f;
#pragma unroll
    for (int s = 0; s < 16; ++s) { const size_t pr = ((size_t)(b * 16 + s) * 128 + 16 * h + tok); const float wgt = __builtin_amdgcn_exp2f(mv[s] - M);
        L += wgt * lv[s]; acc += *(const f32x4*)(PART + pr * 256 + 4 * lane) * wgt; }
    const float rl = 1.0f / L;
    __syncthreads();
    *(LAS f32x4*)(OL + h * 256 + 4 * lane) = acc * rl;
    __syncthreads();
    const bf16* wrow = Wkv_t + (size_t)(512 + h * 64 + lane) * KVL;
    float sum = 0.f;
#pragma unroll 4
    for (int c8 = 0; c8 < 32; ++c8) { const u32x4 wv = *(const u32x4*)(wrow + c8 * 8); const f32x4 o0 = *(const LAS f32x4*)(OL + h * 256 + c8 * 8), o1 = *(const LAS f32x4*)(OL + h * 256 + c8 * 8 + 4);
        sum += o0[0] * __uint_as_float(wv.x << 16) + o0[1] * __uint_as_float(wv.x & 0xffff0000u) + o0[2] * __uint_as_float(wv.y << 16) + o0[3] * __uint_as_float(wv.y & 0xffff0000u)
             + o1[0] * __uint_as_float(wv.z << 16) + o1[1] * __uint_as_float(wv.z & 0xffff0000u) + o1[2] * __uint_as_float(wv.w << 16) + o1[3] * __uint_as_float(wv.w & 0xffff0000u); }
    OMLA[((size_t)TP + b * SSEQ + tok) * 512 + h * 64 + lane] = f2bf(sum);
}

constexpr int M_UH = 0, M_WDW = 62 * 1024, M_END = M_WDW + 31 * 2048;
template <int NR> __device__ __forceinline__ void mix_rows(lptr UH, const LAS float* WDW, int lrow0, size_t grow0, const float* bdw, const float* gcn, const float* bcn,
                                                           const bf16* __restrict__ OMLA, bf16* MIX, int lane) {
    float acc[NR][8];
#pragma unroll
    for (int r = 0; r < NR; ++r)
#pragma unroll
        for (int e = 0; e < 8; ++e) acc[r][e] = bdw[e];
#pragma unroll 1
    for (int j = 0; j < CW; ++j) {
        const f32x4 w0 = *(const LAS f32x4*)(WDW + j * 512 + 8 * lane), w1 = *(const LAS f32x4*)(WDW + j * 512 + 8 * lane + 4);
#pragma unroll
        for (int r = 0; r < NR; ++r) { const u32x4 uv = *(const LAS u32x4*)(UH + (lrow0 + r + j) * 1024 + 16 * lane);
            acc[r][0] += __uint_as_float(uv.x << 16) * w0[0]; acc[r][1] += __uint_as_float(uv.x & 0xffff0000u) * w0[1];
            acc[r][2] += __uint_as_float(uv.y << 16) * w0[2]; acc[r][3] += __uint_as_float(uv.y & 0xffff0000u) * w0[3];
            acc[r][4] += __uint_as_float(uv.z << 16) * w1[0]; acc[r][5] += __uint_as_float(uv.z & 0xffff0000u) * w1[1];
            acc[r][6] += __uint_as_float(uv.w << 16) * w1[2]; acc[r][7] += __uint_as_float(uv.w & 0xffff0000u) * w1[3]; }
    }
#pragma unroll
    for (int r = 0; r < NR; ++r) {
        float s = 0.f;
#pragma unroll
        for (int e = 0; e < 8; ++e) s += acc[r][e];
        const float mu = wave_sum(s) * (1.0f / CC);
        float q = 0.f;
#pragma unroll
        for (int e = 0; e < 8; ++e) { acc[r][e] -= mu; q += acc[r][e] * acc[r][e]; }
        const float rs = rsqrtf(wave_sum(q) * (1.0f / CC) + EPS);
        float q2 = 0.f;
#pragma unroll
        for (int e = 0; e < 8; ++e) { const float ln = acc[r][e] * rs * gcn[e] + bcn[e]; const float co = ln * __builtin_amdgcn_rcpf(1.f + __builtin_amdgcn_exp2f(-1.4426950408889634f * ln)); acc[r][e] = co; q2 += co * co; }
        const float r2 = rsqrtf(wave_sum(q2) * (1.0f / CC) + EPS);
        const size_t row = grow0 + r;
        u32x4 ov; ov.x = cvtpk_s(acc[r][0] * r2, acc[r][1] * r2); ov.y = cvtpk_s(acc[r][2] * r2, acc[r][3] * r2); ov.z = cvtpk_s(acc[r][4] * r2, acc[r][5] * r2); ov.w = cvtpk_s(acc[r][6] * r2, acc[r][7] * r2);
        *(u32x4*)(MIX + row * DM + 512 + 8 * lane) = ov;
        const u32x4 om = *(const u32x4*)(OMLA + row * 512 + 8 * lane);
        float x[8] = {__uint_as_float(om.x << 16), __uint_as_float(om.x & 0xffff0000u), __uint_as_float(om.y << 16), __uint_as_float(om.y & 0xffff0000u),
                      __uint_as_float(om.z << 16), __uint_as_float(om.z & 0xffff0000u), __uint_as_float(om.w << 16), __uint_as_float(om.w & 0xffff0000u)};
        float q3 = 0.f;
#pragma unroll
        for (int e = 0; e < 8; ++e) q3 += x[e] * x[e];
        const float r3 = rsqrtf(wave_sum(q3) * (1.0f / 512.0f) + EPS);
        u32x4 o2; o2.x = cvtpk_s(x[0] * r3, x[1] * r3); o2.y = cvtpk_s(x[2] * r3, x[3] * r3); o2.z = cvtpk_s(x[4] * r3, x[5] * r3); o2.w = cvtpk_s(x[6] * r3, x[7] * r3);
        *(u32x4*)(MIX + row * DM + 8 * lane) = o2;
    }
}
#undef SBAR
}

constexpr int NWAVES = 8;
#ifndef MK_N_LAUNCHES
#define MK_N_LAUNCHES 1
#endif
constexpr int NPHASE = 10;
constexpr int N_LAUNCHES = MK_N_LAUNCHES;

constexpr size_t MiB = 1u << 20;
constexpr size_t WS_CTL = 0, CTL_ZERO_BYTES = 512 * 1024;
constexpr size_t WS_W1 = 1 * MiB, WS_WQ = 5 * MiB, WS_WKV = 6 * MiB, WS_WO = 7 * MiB, WS_WGU = 9 * MiB, WS_WD = 20 * MiB, WS_WUKN = 25 * MiB + 512 * 1024, WS_ROPE = 26 * MiB;
constexpr size_t WS_XN = 27 * MiB, WS_MIX = WS_XN, WS_CQ = 60 * MiB, WS_CKVN = 73 * MiB, WS_KPE = 82 * MiB, WS_U = 84 * MiB, WS_Q = 101 * MiB, WS_ACT = 27 * MiB;
constexpr size_t WS_KN = 126 * MiB, WS_V = 142 * MiB, WS_OMLA = 158 * MiB, WS_HB = 175 * MiB, WS_PART = 208 * MiB, WS_ML = 240 * MiB, WS_END = 241 * MiB;
static_assert(WS_W1 + (size_t)N1 * DM * 2 <= WS_WQ && WS_WQ + (size_t)NQ * QL * 2 <= WS_WKV && WS_WKV + (size_t)NKV * KVL * 2 <= WS_WO && WS_WO + (size_t)DM * DM * 2 <= WS_WGU &&
              WS_WGU + (size_t)NGU * DM * 2 <= WS_WD && WS_WD + (size_t)DM * DFF * 2 <= WS_WUKN && WS_WUKN + (size_t)KVL * 512 * 2 <= WS_ROPE && WS_ROPE + (size_t)NPOS * 16 * 8 <= WS_XN, "weight map");
static_assert(WS_XN + (size_t)T * DM * 2 <= WS_CQ && WS_CQ + (size_t)T * QL * 2 <= WS_CKVN && WS_CKVN + (size_t)T * KVL * 2 <= WS_KPE && WS_KPE + (size_t)T * RD * 2 <= WS_U &&
              WS_U + (size_t)T * CC * 2 <= WS_Q && WS_Q + (size_t)T * NQ * 2 <= WS_KN && WS_ACT + (size_t)T * DFF * 2 <= WS_KN && WS_KN + (size_t)TP * 512 * 2 <= WS_V &&
              WS_V + (size_t)TP * 512 * 2 <= WS_OMLA && WS_OMLA + (size_t)T * 512 * 2 <= WS_HB && WS_HB + (size_t)T * DM * 2 <= WS_PART && WS_PART + (size_t)256 * 128 * 256 * 4 <= WS_ML &&
              WS_ML + (size_t)256 * 128 * 2 * 4 <= WS_END, "activation map");
constexpr int CW_TMO = 0, CW_CODE = 1, CW_BAR = 4096, CW_SSQ_Q = 16384, CW_SSQ_H = CW_SSQ_Q + T;
static_assert((size_t)(CW_SSQ_H + T) * 4 <= CTL_ZERO_BYTES, "CTL words inside the memset region");
constexpr int RING_OFF = 0, RING_BYTES = 131072, EX_OFF = RING_BYTES, LDSCTL_OFF = EX_OFF + 4096, MISC_OFF = LDSCTL_OFF + 320, LDS_BYTES = 147456;
static_assert(MISC_OFF + 128 <= LDS_BYTES && att::L_END <= RING_BYTES && att::D_END <= RING_BYTES && att::M_END <= RING_BYTES, "LDS map");

typedef unsigned short bf16;
typedef unsigned v4u __attribute__((ext_vector_type(4)));
typedef float f32x4 __attribute__((ext_vector_type(4)));
typedef GAS unsigned gu32;
#define RLX_AGENT __ATOMIC_RELAXED, __HIP_MEMORY_SCOPE_AGENT
#define LDS_WAIT() asm volatile("s_waitcnt lgkmcnt(0)" ::: "memory")
#define VM_WAIT() asm volatile("s_waitcnt vmcnt(0)" ::: "memory")
__device__ __forceinline__ unsigned f2bf(float f) { unsigned u = __builtin_bit_cast(unsigned, f); return (u + 0x7fffu + ((u >> 16) & 1u)) >> 16; }
__device__ __forceinline__ unsigned pk2(float lo, float hi) { return f2bf(lo) | (f2bf(hi) << 16); }

#define XB_TMO      128
#define XB_XCNT(j)  (256  + 64 * (j))
#define XB_XSUB(j)  (1280 + 64 * (j))
#define XB_XGEN(j)  (2304 + 64 * (j))
#define XB_TOP      3328
#define XB_TOPGEN   3392
#define XCD_BAR_WORDS 3456
#define XB_SPIN_CAP (1u << 18)

__device__ __forceinline__ unsigned xb_ld(unsigned* p)              { return __hip_atomic_load(p, __ATOMIC_RELAXED, __HIP_MEMORY_SCOPE_AGENT); }
__device__ __forceinline__ unsigned xb_add(unsigned* p, unsigned v) { return __hip_atomic_fetch_add(p, v, __ATOMIC_RELAXED, __HIP_MEMORY_SCOPE_AGENT); }
__device__ __forceinline__ unsigned xb_xcc_id() { return (unsigned)__builtin_amdgcn_s_getreg((3 << 11) | 20) & 0xFu; }
#define XB_SPIN(cond, bar) do { unsigned _sp = 0; while (cond) { __builtin_amdgcn_s_sleep(1); \
    if ((++_sp & 255u) == 0u) { if (xb_ld(&(bar)[XB_TMO])) break; if (_sp > XB_SPIN_CAP) { atomicAdd(&(bar)[XB_TMO], 1u); break; } } } } while (0)

struct XcdBarrier {
    unsigned* bar; unsigned x;
    volatile LAS unsigned* st;
};

__device__ __forceinline__ XcdBarrier xcd_barrier_post(unsigned* bar, volatile LAS unsigned* st) {
    XcdBarrier b; b.bar = bar; b.x = xb_xcc_id(); b.st = st;
    if (threadIdx.x == 0) (void)xb_add(&bar[XB_XCNT(b.x)], 1u);
    return b;
}
__device__ __forceinline__ void xcd_barrier_complete(unsigned* bar, unsigned x, unsigned& nloc, unsigned& nx) {
    const unsigned G = gridDim.x * gridDim.y * gridDim.z;
    unsigned sum, cnt, mine, sp = 0u;
    for (;;) {
        sum = 0u; cnt = 0u; mine = 0u;
#pragma unroll
        for (unsigned j = 0; j < 16; ++j) { const unsigned c = xb_ld(&bar[XB_XCNT(j)]); sum += c; cnt += (c > 0u) ? 1u : 0u; mine = (j == x) ? c : mine; }
        if (sum == G) break;
        __builtin_amdgcn_s_sleep(1);
        if ((++sp & 255u) == 0u) { if (xb_ld(&bar[XB_TMO])) break; if (sp > XB_SPIN_CAP) { atomicAdd(&bar[XB_TMO], 1u); break; } }
    }
    nloc = mine > 0u ? mine : 1u; nx = cnt > 0u ? cnt : 1u;
}

__device__ __forceinline__ void xcd_barrier(const XcdBarrier& b) {
    asm volatile("s_waitcnt vmcnt(0)" ::: "memory");
    __syncthreads();
    if (threadIdx.x == 0) {
        unsigned* bar = b.bar;
        __builtin_amdgcn_s_waitcnt(0);
        unsigned nloc = b.st[0], nx = b.st[1];
        if (nloc == 0u) { xcd_barrier_complete(bar, b.x, nloc, nx); b.st[0] = nloc; b.st[1] = nx; }
        const unsigned old = xb_add(&bar[XB_XSUB(b.x)], 1u);
        const unsigned gen = old / nloc;
        if (old + 1u == (gen + 1u) * nloc) {
            __builtin_amdgcn_fence(__ATOMIC_RELEASE, "agent");
            asm volatile("s_waitcnt vmcnt(0)" ::: "memory");
            const unsigned og = xb_add(&bar[XB_TOP], 1u);
            const unsigned tg = og / nx;
            if (og + 1u == (tg + 1u) * nx) xb_add(&bar[XB_TOPGEN], 1u);
            else XB_SPIN(xb_ld(&bar[XB_TOPGEN]) == tg, bar);
            __builtin_amdgcn_fence(__ATOMIC_ACQUIRE, "agent");
            xb_add(&bar[XB_XGEN(b.x)], 1u);
            asm volatile("s_waitcnt vmcnt(0)" ::: "memory");
        } else {
            XB_SPIN(xb_ld(&bar[XB_XGEN(b.x)]) == gen, bar);
            __builtin_amdgcn_fence(__ATOMIC_ACQUIRE, "agent");
            asm volatile("s_waitcnt vmcnt(0)" ::: "memory");
        }
    }
    __syncthreads();
}


template <class Src> __device__ __forceinline__ void p0_transpose_item(const Src& S, int K, bf16* WT, LAS float* scr, int item, int lane) {
    const int nblk = Src::N / 32, kb = item / nblk, nb = item % nblk, k0 = 64 * kb, n0 = 32 * nb;
#pragma unroll 8
    for (int i = 0; i < 32; ++i) { const int kk = 2 * i + (lane >> 5); scr[kk * 33 + (lane & 31)] = S.load(k0 + kk, n0 + (lane & 31)); }
    LDS_WAIT(); asm volatile("" ::: "memory");
    const int c = lane & 7;
#pragma unroll
    for (int j = 0; j < 4; ++j) { const int n = (lane >> 3) + 8 * j; const LAS float* s = scr + (8 * c) * 33 + n;
        v4u o; o.x = pk2(s[0 * 33], s[1 * 33]); o.y = pk2(s[2 * 33], s[3 * 33]); o.z = pk2(s[4 * 33], s[5 * 33]); o.w = pk2(s[6 * 33], s[7 * 33]);
        *(GAS v4u*)(WT + (size_t)(n0 + n) * K + k0 + 8 * c) = o; }
    LDS_WAIT(); asm volatile("" ::: "memory");
}
struct SrcW1 { static constexpr int N = N1; const float* w;
    __device__ __forceinline__ float load(int k, int n) const { int col;
        if (n < 256) col = QL + n;
        else if (n < 640) col = n - 256;
        else if (n < 672) { const int p = n - 640; col = QL + KVL + ((p >> 2) & 1) * 16 + 4 * (p >> 3) + (p & 3); }
        else if (n < 768) return 0.f;
        else { const int q = (n - 768) & 255, t = (n - 768) >> 8; col = QL + KVL + RD + ((q >> 7) ? CC : 0) + 128 * t + (q & 127); }
        return w[(size_t)k * INW + col]; } };
struct SrcWq { static constexpr int N = NQ; const float* w; const float* g;
    __device__ __forceinline__ float load(int k, int n) const { const int h = n / 96, r = n - h * 96; int col = h * 96 + r;
        if (r >= 64) { const int p = r - 64; col = h * 96 + 64 + ((p >> 2) & 1) * 16 + 4 * (p >> 3) + (p & 3); }
        return w[(size_t)k * NQ + col] * g[k]; } };
struct SrcWkv { static constexpr int N = NKV; const float* w;
    __device__ __forceinline__ float load(int k, int n) const { return w[(size_t)k * 512 + (n & 511)]; } };
struct SrcWo { static constexpr int N = DM; const float* w; const float* g;
    __device__ __forceinline__ float load(int k, int n) const { return w[(size_t)k * DM + n] * g[k & 511]; } };
struct SrcWgu { static constexpr int N = NGU; const float* w; const float* ln;
    __device__ __forceinline__ float load(int k, int n) const { const int t = n >> 8, q = n & 255, j = 128 * t + (q & 127); return w[(size_t)k * DFF + j] * ln[k]; } };
struct SrcWd { static constexpr int N = DM; const float* w;
    __device__ __forceinline__ float load(int k, int n) const { return w[(size_t)k * DM + n]; } };

__device__ __forceinline__ void rms_row(const float* xrow, const float* g, bf16* out_bf, float* out_f32, int lane) {
    const GAS f32x4* xr = (const GAS f32x4*)xrow + lane; const GAS f32x4* gr = (const GAS f32x4*)g + lane;
    f32x4 v[4]; float s = 0.f;
#pragma unroll
    for (int j = 0; j < 4; ++j) { v[j] = xr[64 * j]; s += (v[j].x * v[j].x + v[j].y * v[j].y) + (v[j].z * v[j].z + v[j].w * v[j].w); }
    const float r = rsqrtf(att::wave_sum(s) * (1.0f / DM) + EPS);
#pragma unroll
    for (int j = 0; j < 4; ++j) { const f32x4 o = v[j] * r * gr[64 * j];
        if (out_bf) { GAS unsigned long long* o8 = (GAS unsigned long long*)out_bf + lane; o8[64 * j] = (unsigned long long)pk2(o.x, o.y) | ((unsigned long long)pk2(o.z, o.w) << 32); }
        else ((GAS f32x4*)out_f32 + lane)[64 * j] = o; }
}

struct Args { const float* in[24]; float* out; unsigned char* ws; int ph_lo, ph_hi; };
__global__ void __launch_bounds__(NWAVES * 64, 2) mk_fwd(Args args) {
    extern __shared__ __attribute__((aligned(16))) unsigned char lds[];
    LAS unsigned char* const ldsp = (LAS unsigned char*)lds;
    volatile LAS unsigned* const MISC = (volatile LAS unsigned*)(ldsp + MISC_OFF);
    const int tid0 = threadIdx.x, wave = __builtin_amdgcn_readfirstlane(tid0 >> 6);
#define PHASE_IDS() int tid = tid0; asm volatile("" : "+v"(tid)); const int lane = tid & 63; const int gtid = (int)blockIdx.x * (NWAVES * 64) + tid; (void)lane; (void)gtid
    const int G = gridDim.x; const int vcu = (G % 8 == 0) ? ((int)blockIdx.x % 8) * (G / 8) + (int)blockIdx.x / 8 : (int)blockIdx.x;
    unsigned char* const ws = args.ws; float* const out = args.out;
    gu32* const ctl = (gu32*)(ws + WS_CTL);
    const float *x_p = args.in[0], *x_s = args.in[1], *cache_kv = args.in[2], *cache_kr = args.in[3], *st_conv = args.in[4], *ln_mix = args.in[5], *w_in = args.in[6], *g_q = args.in[7],
                *w_uq = args.in[8], *g_kv = args.in[9], *w_uk = args.in[10], *w_uv = args.in[11], *w_dw = args.in[12], *b_dw = args.in[13], *g_cn = args.in[14], *b_cn = args.in[15],
                *g_om = args.in[16], *g_oc = args.in[17], *w_out = args.in[18], *ln_ffn = args.in[19], *w_gate = args.in[20], *w_up = args.in[21], *w_down = args.in[22], *g_final = args.in[23];
    bf16 *W1t = (bf16*)(ws + WS_W1), *Wq_t = (bf16*)(ws + WS_WQ), *Wkv_t = (bf16*)(ws + WS_WKV), *Wo_t = (bf16*)(ws + WS_WO), *Wgu_t = (bf16*)(ws + WS_WGU), *Wd_t = (bf16*)(ws + WS_WD), *WUKn = (bf16*)(ws + WS_WUKN);
    float* ROPE = (float*)(ws + WS_ROPE);
    bf16 *XN = (bf16*)(ws + WS_XN), *MIX = (bf16*)(ws + WS_MIX), *CQ = (bf16*)(ws + WS_CQ), *CKVN = (bf16*)(ws + WS_CKVN), *KPE = (bf16*)(ws + WS_KPE), *U = (bf16*)(ws + WS_U), *Q = (bf16*)(ws + WS_Q),
         *ACT = (bf16*)(ws + WS_ACT), *KN = (bf16*)(ws + WS_KN), *V = (bf16*)(ws + WS_V), *OMLA = (bf16*)(ws + WS_OMLA), *HB = (bf16*)(ws + WS_HB);
    float *PART = (float*)(ws + WS_PART), *ML = (float*)(ws + WS_ML), *SSQ_Q = (float*)(ws + WS_CTL) + CW_SSQ_Q, *SSQ_H = (float*)(ws + WS_CTL) + CW_SSQ_H, *Y = out + O_Y;

    for (int u = tid0; u < (LDS_BYTES - LDSCTL_OFF) / 4; u += NWAVES * 64) ((LAS unsigned*)(ldsp + LDSCTL_OFF))[u] = 0u;
    __syncthreads();
    XcdBarrier bar; bar.bar = (unsigned*)(ctl + CW_BAR); bar.x = 0; bar.st = nullptr;
    if (N_LAUNCHES != NPHASE) bar = xcd_barrier_post((unsigned*)(ctl + CW_BAR), MISC + 8);
#define GRID_BAR() do { if (N_LAUNCHES == NPHASE) { if (tid0 == 0) __hip_atomic_store(ctl + CW_TMO, 0xBADBA0u, RLX_AGENT); } else { xcd_barrier(bar); } } while (0)
    const int lo = args.ph_lo, hi = args.ph_hi;
#define IN(k) (lo <= (k) && (k) < hi)
#define BOTH(k) (IN(k) && IN((k) + 1))
    const int gw = vcu * NWAVES + wave, NGW = G * NWAVES, NGT = G * NWAVES * 64;

    if (IN(0)) {
        PHASE_IDS();
        LAS float* scr = (LAS float*)(ldsp + RING_OFF + wave * 16384);
        constexpr int I_1 = (DM / 64) * (N1 / 32), I_Q = (QL / 64) * (NQ / 32), I_KV = (KVL / 64) * (NKV / 32), I_O = (DM / 64) * (DM / 32), I_GU = (DM / 64) * (NGU / 32), I_D = (DFF / 64) * (DM / 32);
        constexpr int NITEMS = I_1 + I_Q + I_KV + I_O + I_GU + I_D;
        for (int it = gw; it < NITEMS; it += NGW) {
            int r = it;
            if (r < I_1) { p0_transpose_item(SrcW1{w_in}, DM, W1t, scr, r, lane); continue; } r -= I_1;
            if (r < I_Q) { p0_transpose_item(SrcWq{w_uq, g_q}, QL, Wq_t, scr, r, lane); continue; } r -= I_Q;
            if (r < I_KV) { const bool second = (r % (NKV / 32)) * 32 >= 512; p0_transpose_item(SrcWkv{second ? w_uv : w_uk}, KVL, Wkv_t, scr, r, lane); continue; } r -= I_KV;
            if (r < I_O) { const bool second = (r / (DM / 32)) * 64 >= 512; p0_transpose_item(SrcWo{w_out, second ? g_oc : g_om}, DM, Wo_t, scr, r, lane); continue; } r -= I_O;
            if (r < I_GU) { const bool up = (((r % (NGU / 32)) * 32) & 255) >= 128; p0_transpose_item(SrcWgu{up ? w_up : w_gate, ln_ffn}, DM, Wgu_t, scr, r, lane); continue; } r -= I_GU;
            p0_transpose_item(SrcWd{w_down}, DFF, Wd_t, scr, r, lane);
        }
        for (int m = gw; m < T; m += NGW) rms_row(m < TP ? x_p + (size_t)m * DM : x_s + (size_t)(m - TP) * DM, ln_mix, XN + (size_t)m * DM, nullptr, lane);
        for (int i = gtid; i < NPOS * 16; i += NGT) { const int pi = i >> 4, fi = i & 15; const int pos = pi < SEQ ? pi : PAST + (pi - SEQ);
            const double ang = (double)pos * exp2(-(double)fi * 0.8304820237218406);
            ROPE[2 * i] = (float)cos(ang); ROPE[2 * i + 1] = (float)sin(ang); }
        for (int i = gtid; i < KVL * 512 / 4; i += NGT) { const f32x4 v = *(const f32x4*)(w_uk + (size_t)i * 4); *(unsigned long long*)(WUKn + (size_t)i * 4) = (unsigned long long)pk2(v.x, v.y) | ((unsigned long long)pk2(v.z, v.w) << 32); }
        for (int i = gtid; i < SBATCH * (CST - SSEQ) * CC / 4; i += NGT) { const int c4 = i % (CC / 4), r = (i / (CC / 4)) % (CST - SSEQ), b = i / ((CC / 4) * (CST - SSEQ));
            *(f32x4*)(out + O_CVS + ((size_t)b * CST + r) * CC + c4 * 4) = *(const f32x4*)(st_conv + ((size_t)b * CST + SSEQ + r) * CC + c4 * 4); }
        if (BOTH(0)) GRID_BAR();
    }
    if (IN(1)) {
        pg8::Gemm g{XN, W1t, T, N1, DM}; pg8::StaticOrder S; S.init(T, N1, G, (int)blockIdx.x);
        pg8::EpiProj E{CKVN, CQ, KPE, U, out, SSQ_Q, g_kv, ROPE, (LAS float*)(ldsp + EX_OFF)};
        pg8::gemm_phase<pg8::EpiProj, pg8::StaticOrder, true, true>(ldsp + RING_OFF, g, S, E);
        if (BOTH(1)) GRID_BAR();
    }
    if (IN(2)) {
        { pg8::Gemm g{CQ, Wq_t, T, NQ, QL}; pg8::StaticOrder S; S.init(T, NQ, G, (int)blockIdx.x);
          pg8::EpiQ E{Q, SSQ_Q, ROPE};
          pg8::gemm_phase<pg8::EpiQ, pg8::StaticOrder, true, true>(ldsp + RING_OFF, g, S, E); }
        { pg8::Gemm g{CKVN, Wkv_t, TP, NKV, KVL}; pg8::StaticOrder S; S.init(TP, NKV, G, (int)blockIdx.x);
          pg8::EpiBf16 E{KN, 512, 512, (size_t)(WS_V - WS_KN) / 2};
          pg8::gemm_phase<pg8::EpiBf16, pg8::StaticOrder, true, true>(ldsp + RING_OFF, g, S, E); }
        if (BOTH(2)) GRID_BAR();
    }
    if (IN(3)) {
        PHASE_IDS();
        for (int p = vcu; p < 256; p += G) { const int bh = p >> 2, s = p & 3;
            att::prompt_unit(bh >> 3, bh & 7, 7 - s, Q, KN, KPE, V, OMLA, (char*)lds + RING_OFF);
            att::prompt_unit(bh >> 3, bh & 7, s, Q, KN, KPE, V, OMLA, (char*)lds + RING_OFF); }
        for (int p = vcu; p < 256; p += G) att::decode_unit(p >> 4, p & 15, Q, WUKn, cache_kv, cache_kr, CKVN, KPE, PART, ML, (att::lptr)(ldsp + RING_OFF));
        if (BOTH(3)) GRID_BAR();
    }
    if (IN(4)) {
        PHASE_IDS();
        for (int p = vcu; p < 256; p += G) att::combine_item(p >> 4, p & 15, PART, ML, Wkv_t, OMLA, (att::lptr)(ldsp + RING_OFF));
        if (BOTH(4)) GRID_BAR();
    }
    if (IN(5)) {
        PHASE_IDS();
        const att::lptr UH = (att::lptr)(ldsp + RING_OFF + att::M_UH); LAS float* WDW = (LAS float*)(ldsp + RING_OFF + att::M_WDW);
        __syncthreads();
        for (int i = tid; i < CW * CC / 4; i += NWAVES * 64) *(LAS f32x4*)(WDW + 4 * i) = *(const f32x4*)(w_dw + 4 * i);
        float bdw[8], gcn[8], bcn[8];
#pragma unroll
        for (int e = 0; e < 8; ++e) { bdw[e] = b_dw[8 * lane + e]; gcn[e] = g_cn[8 * lane + e]; bcn[e] = b_cn[8 * lane + e]; }
        for (int it = vcu; it < 512 + SBATCH; it += G) {
            __syncthreads();
            if (it < 512) { const int r0 = it * 32, b = r0 >> 11, s0 = r0 & (SEQ - 1);
                for (int i = tid; i < 62 * 64; i += NWAVES * 64) { const int lr = i >> 6, ch = i & 63, s = s0 - CST + lr;
                    v4u v = {0u, 0u, 0u, 0u}; if (s >= 0) v = *(const v4u*)(U + ((size_t)b * SEQ + s) * CC + ch * 8);
                    *(LAS v4u*)(UH + lr * 1024 + ch * 16) = v; }
                __syncthreads();
                att::mix_rows<4>(UH, WDW, wave * 4, (size_t)r0 + wave * 4, bdw, gcn, bcn, OMLA, MIX, lane);
            } else { const int bs = it - 512;
                for (int i = tid; i < 46 * 64; i += NWAVES * 64) { const int lr = i >> 6, ch = i & 63; v4u v;
                    if (lr < CST) { const float* sp = st_conv + ((size_t)bs * CST + lr) * CC + ch * 8; const f32x4 a = *(const f32x4*)sp, c = *(const f32x4*)(sp + 4);
                        v.x = pk2(a.x, a.y); v.y = pk2(a.z, a.w); v.z = pk2(c.x, c.y); v.w = pk2(c.z, c.w); }
                    else v = *(const v4u*)(U + ((size_t)TP + bs * SSEQ + (lr - CST)) * CC + ch * 8);
                    *(LAS v4u*)(UH + lr * 1024 + ch * 16) = v; }
                __syncthreads();
                att::mix_rows<2>(UH, WDW, wave * 2, (size_t)TP + bs * SSEQ + wave * 2, bdw, gcn, bcn, OMLA, MIX, lane);
            }
        }
        if (BOTH(5)) GRID_BAR();
    }
    if (IN(6)) {
        pg8::Gemm g{MIX, Wo_t, T, DM, DM}; pg8::StaticOrder S; S.init(T, DM, G, (int)blockIdx.x);
        pg8::EpiWo E{x_p, x_s, Y, HB, SSQ_H};
        pg8::gemm_phase<pg8::EpiWo, pg8::StaticOrder, true, true>(ldsp + RING_OFF, g, S, E);
        if (BOTH(6)) GRID_BAR();
    }
    if (IN(7)) {
        pg8::Gemm g{HB, Wgu_t, T, NGU, DM}; pg8::StaticOrder S; S.init(T, NGU, G, (int)blockIdx.x);
        pg8::EpiGU E{ACT, SSQ_H};
        pg8::gemm_phase<pg8::EpiGU, pg8::StaticOrder, true, true>(ldsp + RING_OFF, g, S, E);
        if (BOTH(7)) GRID_BAR();
    }
    if (IN(8)) {
        pg8::Gemm g{ACT, Wd_t, T, DM, DFF}; pg8::StaticOrder S; S.init(T, DM, G, (int)blockIdx.x);
        pg8::EpiDown E{Y};
        pg8::gemm_phase<pg8::EpiDown, pg8::StaticOrder, true, true>(ldsp + RING_OFF, g, S, E);
        if (BOTH(8)) GRID_BAR();
    }
    if (IN(9)) {
        PHASE_IDS();
        for (int m = gw; m < T; m += NGW) rms_row(Y + (size_t)m * DM, g_final, nullptr, Y + (size_t)m * DM, lane);
    }
#undef IN
#undef BOTH
}

extern "C" void kernel_launch(void* const* d_in, const int* in_sizes, int n_in, void* d_out, int out_size, void* d_ws, size_t ws_size, hipStream_t stream) {
    static int grid = 0;
    if (grid == 0) {
        if (n_in != 24 || in_sizes[0] != TP * DM || (size_t)out_size != O_END || ws_size < WS_END) { fprintf(stderr, "kernel_launch: shape mismatch (n_in %d, in0 %d, out %d, ws %zu); nothing launched\n", n_in, n_in > 0 ? in_sizes[0] : -1, out_size, ws_size); grid = -1; return; }
        int dev = 0, cus = 0, per_cu = 0;
        if (hipGetDevice(&dev) != hipSuccess || hipDeviceGetAttribute(&cus, hipDeviceAttributeMultiprocessorCount, dev) != hipSuccess) { fprintf(stderr, "kernel_launch: device query failed\n"); grid = -1; return; }
        if (hipFuncSetAttribute((const void*)mk_fwd, hipFuncAttributeMaxDynamicSharedMemorySize, LDS_BYTES) != hipSuccess) { fprintf(stderr, "kernel_launch: hipFuncSetAttribute failed\n"); grid = -1; return; }
        if (hipOccupancyMaxActiveBlocksPerMultiprocessor(&per_cu, (const void*)mk_fwd, NWAVES * 64, LDS_BYTES) != hipSuccess || per_cu < 1) { fprintf(stderr, "kernel_launch: occupancy query says %d workgroups per CU; nothing launched\n", per_cu); (void)hipGetLastError(); grid = -1; return; }
        grid = cus;
    }
    if (grid < 0) return;
    if (hipMemsetAsync((char*)d_ws + WS_CTL, 0, CTL_ZERO_BYTES, stream) != hipSuccess) { fprintf(stderr, "kernel_launch: hipMemsetAsync failed\n"); return; }
    Args a{};
    for (int i = 0; i < 24; ++i) a.in[i] = (const float*)d_in[i];
    a.out = (float*)d_out; a.ws = (unsigned char*)d_ws;
    for (int li = 0; li < N_LAUNCHES; ++li) {
        a.ph_lo = (N_LAUNCHES == NPHASE) ? li : 0; a.ph_hi = (N_LAUNCHES == NPHASE) ? li + 1 : NPHASE;
        hipLaunchKernelGGL(mk_fwd, dim3(grid), dim3(NWAVES * 64), LDS_BYTES, stream, a);
        const hipError_t le = hipPeekAtLastError();
        if (le != hipSuccess) { fprintf(stderr, "kernel_launch: launch %d failed: %s\n", li, hipGetErrorName(le)); break; }
    }
}
```

```cpp
#include <hip/hip_runtime.h>
#include <hip/hip_bf16.h>
#include <cstdio>
#include <cstdint>
#include <cmath>
#define LAS __attribute__((address_space(3)))
#define GAS __attribute__((address_space(1)))

constexpr int DM = 1024, NBATCH = 8, SEQ = 2048, SBATCH = 16, SSEQ = 16, PAST = 4096;
constexpr int TP = NBATCH * SEQ, TS = SBATCH * SSEQ, T = TP + TS;
constexpr int QL = 384, KVL = 256, RD = 32, CC = 512, INW = 1696, NH = 8, DFF = 2816, CW = 31, CST = 30;
constexpr int N1 = 1792, NQ = 768, NKV = 1024, NGU = 2 * DFF;
constexpr float EPS = 1e-6f;
constexpr float QSCALE = 0.10206207261596575f * 1.4426950408889634f;
constexpr int NPOS = SEQ + SSEQ;
constexpr size_t O_Y = 0, O_KVP = (size_t)T * DM, O_KRP = O_KVP + (size_t)TP * KVL, O_CVP = O_KRP + (size_t)TP * RD,
                 O_KVS = O_CVP + (size_t)NBATCH * CST * CC, O_KRS = O_KVS + (size_t)TS * KVL, O_CVS = O_KRS + (size_t)TS * RD, O_END = O_CVS + (size_t)SBATCH * CST * CC;
__device__ __forceinline__ int posidx(int row) { return row < TP ? (row & (SEQ - 1)) : SEQ + ((row - TP) & (SSEQ - 1)); }

namespace pg8 {
#define PG8_LAS __attribute__((address_space(3)))
typedef unsigned short bf16_t;
typedef short bf16x8 __attribute__((ext_vector_type(8)));
typedef float f32x4 __attribute__((ext_vector_type(4)));
typedef unsigned u32x4 __attribute__((ext_vector_type(4)));
constexpr int BM = 256, BK = 64, HALF = 128, HTB = HALF * BK * 2  , STAGE_BYTES = 8 * HTB, NXCD = 8, WGM = 8;

__host__ __device__ __forceinline__ int lds_byte(int r, int c) { const int st = (r >> 4) * 2 + (c >> 5), rr = r & 15, cc = c & 31, ob = rr * 64 + cc * 2; return st * 1024 + (ob ^ (((ob >> 9) & 1) << 5)); }
__host__ __device__ __forceinline__ void stage_rc(int b, int& R, int& C) { const int st = b / 1024, sb = b % 1024, swz = sb ^ (((sb >> 9) & 1) << 5); R = (st >> 1) * 16 + swz / 64; C = (st & 1) * 32 + (swz % 64) / 2; }
__host__ __device__ __forceinline__ int perm32(int rho) { const int n = rho >> 4, i = rho & 15; return 8 * (i >> 2) + 4 * n + (i & 3); }

struct Unit { int pm, pn, kt0, nt, kind; };
struct Gemm { const bf16_t* A; const bf16_t* Bt; int M, N, K; };

struct StaticOrder {
    int nM, nN, nwg, G, c;
    __host__ __device__ void init(int M, int N, int G_, int c_) { nM = M / BM; nN = N / BM; nwg = nM * nN; G = G_; c = c_; }
    __host__ __device__ bool next(int i, Unit& u) const {
        const long L = (long)i * G + c; if (L >= nwg) return false;
        int wgid = (int)L; { const int q = nwg / NXCD, r = nwg % NXCD, xcd = wgid % NXCD, off = wgid / NXCD; wgid = (xcd < r ? xcd * (q + 1) : r * (q + 1) + (xcd - r) * q) + off; }
        const int nig = WGM * nN, gid = wgid / nig, fm = gid * WGM, gsz = (nM - fm) < WGM ? (nM - fm) : WGM;
        u.pm = fm + ((wgid % nig) % gsz); u.pn = (wgid % nig) / gsz; u.kt0 = 0; u.nt = 0; u.kind = 0; return true;
    }
    __device__ __forceinline__ void a_ready(const Unit&) const {}
    __device__ __forceinline__ void done(const Unit&) const {}
};


__device__ __forceinline__ unsigned cvt_pk_bf16(float lo, float hi) { unsigned r; asm volatile("v_cvt_pk_bf16_f32 %0, %1, %2" : "=v"(r) : "v"(lo), "v"(hi)); return r; }
__device__ __forceinline__ u32x4 pack8(f32x4 a, f32x4 b) { u32x4 w; w.x = cvt_pk_bf16(a[0], a[1]); w.y = cvt_pk_bf16(a[2], a[3]); w.z = cvt_pk_bf16(b[0], b[1]); w.w = cvt_pk_bf16(b[2], b[3]); return w; }
__device__ __forceinline__ float sq4(f32x4 v) { return (v[0] * v[0] + v[1] * v[1]) + (v[2] * v[2] + v[3] * v[3]); }
__device__ __forceinline__ float sigm(float x) { return __builtin_amdgcn_rcpf(1.f + __builtin_amdgcn_exp2f(-1.4426950408889634f * x)); }
__device__ __forceinline__ f32x4 sigm4(f32x4 x) { return (f32x4){sigm(x[0]), sigm(x[1]), sigm(x[2]), sigm(x[3])}; }
__device__ __forceinline__ void rope4(const float* tab, f32x4& x1, f32x4& x2) {
    const f32x4 t0 = *(const f32x4*)tab, t1 = *(const f32x4*)(tab + 4);
    const f32x4 c = {t0[0], t0[2], t1[0], t1[2]}, s = {t0[1], t0[3], t1[1], t1[3]};
    const f32x4 y1 = x1 * c - x2 * s, y2 = x2 * c + x1 * s; x1 = y1; x2 = y2;
}

struct EpiBf16 {
    static constexpr bool PERM = true, AFTER_DRAIN = false, HAS_INIT = false;
    bf16_t* O; int ldc; int split_cols; size_t split_stride;
    __device__ __forceinline__ void operator()(const f32x4 (&acc)[2][2][4][2], const Unit& u, int wr, int wc, int fr, int fq) const {
        const int row0 = u.pm * BM + wr * 64 + fr; int colt = u.pn * BM; bf16_t* base = O;
        if (split_cols) { const int t = colt / split_cols; base += (size_t)t * split_stride; colt -= t * split_cols; }
        const int col0 = colt + wc * 32 + 8 * fq;
#pragma unroll
        for (int ai = 0; ai < 2; ++ai)
#pragma unroll
            for (int m = 0; m < 4; ++m) { bf16_t* rowp = base + (size_t)(row0 + ai * HALF + m * 16) * ldc + col0;
#pragma unroll
                for (int bj = 0; bj < 2; ++bj) *(u32x4*)(rowp + bj * HALF) = pack8(acc[ai][bj][m][0], acc[ai][bj][m][1]); }
    }
};

struct EpiProj {
    static constexpr bool PERM = true, AFTER_DRAIN = false, HAS_INIT = false;
    bf16_t *CKVN, *CQ, *KPE, *U; float* out; float* ssq_q; const float* g_kv; const float* rope; PG8_LAS float* ex;
    __device__ __forceinline__ void operator()(const f32x4 (&acc)[2][2][4][2], const Unit& u, int wr, int wc, int fr, int fq) const {
        const bool smp = (u.pm == TP / BM);
        const int rl0 = wr * 64 + fr;
        if (u.pn == 0) {
#pragma unroll
            for (int ai = 0; ai < 2; ++ai)
#pragma unroll
                for (int m = 0; m < 4; ++m) { float s = 0.f;
#pragma unroll
                    for (int bj = 0; bj < 2; ++bj) s += sq4(acc[ai][bj][m][0]) + sq4(acc[ai][bj][m][1]);
                    s += __shfl_xor(s, 16); s += __shfl_xor(s, 32);
                    if (fq == 0) ex[(ai * HALF + rl0 + m * 16) * 4 + wc] = s; }
            asm volatile("s_waitcnt lgkmcnt(0)" ::: "memory"); __builtin_amdgcn_s_barrier(); asm volatile("" ::: "memory");
            const int c0 = wc * 32 + 8 * fq;
            f32x4 g[2][2];
#pragma unroll
            for (int bj = 0; bj < 2; ++bj)
#pragma unroll
                for (int n = 0; n < 2; ++n) g[bj][n] = *(const f32x4*)(g_kv + c0 + bj * HALF + 4 * n);
            float* okv = smp ? out + O_KVS : out + O_KVP + (size_t)u.pm * BM * KVL;
#pragma unroll
            for (int ai = 0; ai < 2; ++ai)
#pragma unroll
                for (int m = 0; m < 4; ++m) { const int rl = ai * HALF + rl0 + m * 16; const f32x4 e = *(const PG8_LAS f32x4*)(ex + rl * 4);
                    const float r = rsqrtf(((e[0] + e[1]) + (e[2] + e[3])) * (1.0f / KVL) + EPS);
                    float* of = okv + (size_t)rl * KVL + c0; bf16_t* ob = CKVN + ((size_t)u.pm * BM + rl) * KVL + c0;
#pragma unroll
                    for (int bj = 0; bj < 2; ++bj) { const f32x4 v0 = acc[ai][bj][m][0] * r * g[bj][0], v1 = acc[ai][bj][m][1] * r * g[bj][1];
                        *(f32x4*)(of + bj * HALF) = v0; *(f32x4*)(of + bj * HALF + 4) = v1; *(u32x4*)(ob + bj * HALF) = pack8(v0, v1); } }
        } else if (u.pn <= 2) {
            const int nbj = (u.pn == 1) ? 2 : 1;
            const int cq0 = (u.pn - 1) * BM + wc * 32 + 8 * fq;
#pragma unroll
            for (int ai = 0; ai < 2; ++ai)
#pragma unroll
                for (int m = 0; m < 4; ++m) { const size_t row = (size_t)u.pm * BM + ai * HALF + rl0 + m * 16; float s = 0.f;
#pragma unroll
                    for (int bj = 0; bj < 2; ++bj) if (bj < nbj) { const f32x4 v0 = acc[ai][bj][m][0], v1 = acc[ai][bj][m][1]; s += sq4(v0) + sq4(v1);
                        *(u32x4*)(CQ + row * QL + cq0 + bj * HALF) = pack8(v0, v1); }
                    s += __shfl_xor(s, 16); s += __shfl_xor(s, 32);
                    if (fq == 0) atomicAdd(ssq_q + row, s);
                    if (u.pn == 2 && wc == 0) { f32x4 x1 = acc[ai][1][m][0], x2 = acc[ai][1][m][1];
                        rope4(rope + ((size_t)posidx((int)row) * 16 + 4 * fq) * 2, x1, x2);
                        float* okr = smp ? out + O_KRS + (row - TP) * RD : out + O_KRP + row * RD;
                        *(f32x4*)(okr + 4 * fq) = x1; *(f32x4*)(okr + 16 + 4 * fq) = x2; *(u32x4*)(KPE + row * RD + 8 * fq) = pack8(x1, x2); } }
        } else {
            const int cu = (u.pn - 3) * HALF + wc * 32 + 8 * fq;
            const bool cvp = !smp && ((u.pm & 7) == 7);
#pragma unroll
            for (int ai = 0; ai < 2; ++ai)
#pragma unroll
                for (int m = 0; m < 4; ++m) { const int rl = ai * HALF + rl0 + m * 16; const size_t row = (size_t)u.pm * BM + rl;
                    const f32x4 u0 = acc[ai][0][m][0] * sigm4(acc[ai][1][m][0]), u1 = acc[ai][0][m][1] * sigm4(acc[ai][1][m][1]);
                    *(u32x4*)(U + row * CC + cu) = pack8(u0, u1);
                    if (smp) { const int r = rl, b = r >> 4, s = r & 15; float* o = out + O_CVS + ((size_t)b * CST + (CST - SSEQ) + s) * CC + cu; *(f32x4*)o = u0; *(f32x4*)(o + 4) = u1; }
                    else if (cvp && rl >= BM - CST) { float* o = out + O_CVP + ((size_t)(u.pm >> 3) * CST + (rl - (BM - CST))) * CC + cu; *(f32x4*)o = u0; *(f32x4*)(o + 4) = u1; } }
        }
    }
};

struct EpiQ {
    static constexpr bool PERM = true, AFTER_DRAIN = false, HAS_INIT = false;
    bf16_t* Q; const float* ssq_q; const float* rope;
    __device__ __forceinline__ void operator()(const f32x4 (&acc)[2][2][4][2], const Unit& u, int wr, int wc, int fr, int fq) const {
        float rr[2][4];
#pragma unroll
        for (int ai = 0; ai < 2; ++ai)
#pragma unroll
            for (int m = 0; m < 4; ++m) rr[ai][m] = ssq_q[(size_t)u.pm * BM + ai * HALF + wr * 64 + m * 16 + fr];
#pragma unroll
        for (int ai = 0; ai < 2; ++ai)
#pragma unroll
            for (int m = 0; m < 4; ++m) { const size_t row = (size_t)u.pm * BM + ai * HALF + wr * 64 + m * 16 + fr;
                const float rq = rsqrtf(rr[ai][m] * (1.0f / QL) + EPS) * QSCALE; const float* tab = rope + (size_t)posidx((int)row) * 32;
#pragma unroll
                for (int bj = 0; bj < 2; ++bj) { const int c0 = u.pn * BM + bj * HALF + wc * 32 + 8 * fq; const int gi = (c0 >> 3) % 12;
                    f32x4 v0 = acc[ai][bj][m][0] * rq, v1 = acc[ai][bj][m][1] * rq;
                    const int g = gi >= 8 ? gi - 8 : 0; f32x4 y1 = v0, y2 = v1; rope4(tab + g * 8, y1, y2);
                    if (gi >= 8) { v0 = y1; v1 = y2; }
                    *(u32x4*)(Q + row * NQ + c0) = pack8(v0, v1); }
                asm volatile("" ::: "memory"); }
    }
};

struct PanelSplitOrder {
    StaticOrder so; int nmini, mt;
    __device__ __forceinline__ void init(int G_, int c_, int K, int mt_, bool minis = true) { so.init(TP, DM, G_, c_); mt = mt_; nmini = minis ? 4 * (K / BK / mt_) : 0; }
    __device__ __forceinline__ bool next(int i, Unit& u) const {
        const long L = (long)i * so.G + so.c;
        if (L < so.nwg) return so.next(i, u);
        const int m = (int)(L - so.nwg); if (m >= nmini) return false;
        u.pm = TP / BM; u.pn = m & 3; u.kt0 = (m >> 2) * mt; u.nt = mt; u.kind = 1; return true;
    }
    __device__ __forceinline__ void a_ready(const Unit&) const {}
    __device__ __forceinline__ void done(const Unit&) const {}
};

struct EpiWo {
    static constexpr bool PERM = true, AFTER_DRAIN = false, HAS_INIT = true;
    const float* xp; bf16_t* HB; float* ssq_h; float* SLAB; int mt; int probe;
    __device__ __forceinline__ void init(f32x4 (&acc)[2][2][4][2], const Unit& u, int wr, int wc, int fr, int fq) const {
        const int cb = u.pn * BM + wc * 32 + 8 * fq;
        if (u.kind == 0) {
#pragma unroll
            for (int ai = 0; ai < 2; ++ai)
#pragma unroll
                for (int m = 0; m < 4; ++m) { const float* xr = xp + ((size_t)u.pm * BM + ai * HALF + wr * 64 + m * 16 + fr) * DM + cb;
#pragma unroll
                    for (int bj = 0; bj < 2; ++bj)
#pragma unroll
                        for (int n = 0; n < 2; ++n) acc[ai][bj][m][n] = *(const f32x4*)(xr + bj * HALF + 4 * n); }
        } else {
#pragma unroll
            for (int ai = 0; ai < 2; ++ai)
#pragma unroll
                for (int m = 0; m < 4; ++m)
#pragma unroll
                    for (int bj = 0; bj < 2; ++bj)
#pragma unroll
                        for (int n = 0; n < 2; ++n) acc[ai][bj][m][n] = (f32x4){0.f, 0.f, 0.f, 0.f};
        }
    }
    __device__ __forceinline__ void operator()(const f32x4 (&acc)[2][2][4][2], const Unit& u, int wr, int wc, int fr, int fq) const {
        const int cb = u.pn * BM + wc * 32 + 8 * fq;
        if (probe == 2) {
#pragma unroll
            for (int ai = 0; ai < 2; ++ai)
#pragma unroll
                for (int bj = 0; bj < 2; ++bj)
#pragma unroll
                    for (int m = 0; m < 4; ++m) asm volatile("" :: "v"(acc[ai][bj][m][0]), "v"(acc[ai][bj][m][1]));
            return; }
        if (u.kind == 0) {
#pragma unroll
            for (int ai = 0; ai < 2; ++ai)
#pragma unroll
                for (int m = 0; m < 4; ++m) { const size_t row = (size_t)u.pm * BM + ai * HALF + wr * 64 + m * 16 + fr; float s = 0.f;
#pragma unroll
                    for (int bj = 0; bj < 2; ++bj) { *(u32x4*)(HB + row * DM + cb + bj * HALF) = pack8(acc[ai][bj][m][0], acc[ai][bj][m][1]); s += sq4(acc[ai][bj][m][0]) + sq4(acc[ai][bj][m][1]); }
                    s += __shfl_xor(s, 16); s += __shfl_xor(s, 32);
                    if (fq == 0) atomicAdd(ssq_h + row, s); }
        } else { const int sl = u.kt0 / mt;
#pragma unroll
            for (int ai = 0; ai < 2; ++ai)
#pragma unroll
                for (int m = 0; m < 4; ++m) { const int rl = ai * HALF + wr * 64 + m * 16 + fr;
#pragma unroll
                    for (int bj = 0; bj < 2; ++bj) { float* sp = SLAB + ((size_t)sl * BM + rl) * DM + cb + bj * HALF; *(f32x4*)sp = acc[ai][bj][m][0]; *(f32x4*)(sp + 4) = acc[ai][bj][m][1]; } }
        }
    }
};

struct EpiGU {
    static constexpr bool PERM = true, AFTER_DRAIN = false, HAS_INIT = false;
    bf16_t* ACT; const float* ssq_h;
    __device__ __forceinline__ void operator()(const f32x4 (&acc)[2][2][4][2], const Unit& u, int wr, int wc, int fr, int fq) const {
        const int c0 = u.pn * HALF + wc * 32 + 8 * fq;
        float rr[2][4];
#pragma unroll
        for (int ai = 0; ai < 2; ++ai)
#pragma unroll
            for (int m = 0; m < 4; ++m) rr[ai][m] = ssq_h[(size_t)u.pm * BM + ai * HALF + wr * 64 + m * 16 + fr];
#pragma unroll
        for (int ai = 0; ai < 2; ++ai)
#pragma unroll
            for (int m = 0; m < 4; ++m) { const size_t row = (size_t)u.pm * BM + ai * HALF + wr * 64 + m * 16 + fr;
                const float r = rsqrtf(rr[ai][m] * (1.0f / DM) + EPS);
                const f32x4 g0 = acc[ai][0][m][0] * r, g1 = acc[ai][0][m][1] * r, u0 = acc[ai][1][m][0] * r, u1 = acc[ai][1][m][1] * r;
                *(u32x4*)(ACT + row * DFF + c0) = pack8(g0 * sigm4(g0) * u0, g1 * sigm4(g1) * u1); }
    }
};

struct EpiDown {
    static constexpr bool PERM = true, AFTER_DRAIN = false, HAS_INIT = true;
    bf16_t* H2; const bf16_t* HB; float* SLAB; int mt;
    __device__ __forceinline__ void init(f32x4 (&acc)[2][2][4][2], const Unit& u, int wr, int wc, int fr, int fq) const {
        const int cb = u.pn * BM + wc * 32 + 8 * fq;
        if (u.kind == 0) {
#pragma unroll
            for (int ai = 0; ai < 2; ++ai)
#pragma unroll
                for (int m = 0; m < 4; ++m) { const bf16_t* p = HB + ((size_t)u.pm * BM + ai * HALF + wr * 64 + m * 16 + fr) * DM + cb;
#pragma unroll
                    for (int bj = 0; bj < 2; ++bj) { const u32x4 h = *(const u32x4*)(p + bj * HALF);
                        acc[ai][bj][m][0] = (f32x4){__uint_as_float(h.x << 16), __uint_as_float(h.x & 0xffff0000u), __uint_as_float(h.y << 16), __uint_as_float(h.y & 0xffff0000u)};
                        acc[ai][bj][m][1] = (f32x4){__uint_as_float(h.z << 16), __uint_as_float(h.z & 0xffff0000u), __uint_as_float(h.w << 16), __uint_as_float(h.w & 0xffff0000u)}; } }
        } else {
#pragma unroll
            for (int ai = 0; ai < 2; ++ai)
#pragma unroll
                for (int m = 0; m < 4; ++m)
#pragma unroll
                    for (int bj = 0; bj < 2; ++bj)
#pragma unroll
                        for (int n = 0; n < 2; ++n) acc[ai][bj][m][n] = (f32x4){0.f, 0.f, 0.f, 0.f};
        }
    }
    __device__ __forceinline__ void operator()(const f32x4 (&acc)[2][2][4][2], const Unit& u, int wr, int wc, int fr, int fq) const {
        const int sl = u.kt0 / mt; const int cb = u.pn * BM + wc * 32 + 8 * fq;
        if (u.kind == 0) {
#pragma unroll
            for (int ai = 0; ai < 2; ++ai)
#pragma unroll
                for (int m = 0; m < 4; ++m) { bf16_t* p = H2 + ((size_t)u.pm * BM + ai * HALF + wr * 64 + m * 16 + fr) * DM + cb;
#pragma unroll
                    for (int bj = 0; bj < 2; ++bj) *(u32x4*)(p + bj * HALF) = pack8(acc[ai][bj][m][0], acc[ai][bj][m][1]); }
        } else {
#pragma unroll
            for (int ai = 0; ai < 2; ++ai)
#pragma unroll
                for (int m = 0; m < 4; ++m) { const int rl = ai * HALF + wr * 64 + m * 16 + fr;
#pragma unroll
                    for (int bj = 0; bj < 2; ++bj) { float* p = SLAB + ((size_t)sl * BM + rl) * DM + cb + bj * HALF; *(f32x4*)p = acc[ai][bj][m][0]; *(f32x4*)(p + 4) = acc[ai][bj][m][1]; } }
        }
    }
};

template <class Epi, class Sched, bool ALIGN_EPI = false, bool SP2 = false>
__device__ __forceinline__ void gemm_phase(PG8_LAS unsigned char* lds, const Gemm g, const Sched& S, const Epi& E) {
    int tid_ = threadIdx.x; asm volatile("" : "+v"(tid_));
    const int tid = tid_, wid = __builtin_amdgcn_readfirstlane(tid >> 6), lane = tid & 63, wr = wid >> 2, wc = wid & 3, fr = lane & 15, fq = lane >> 4;
    int K_ = g.K; asm volatile("" : "+s"(K_));
    const int K = K_, nt = K / BK;
    unsigned voffA[2], voffB[2];
#pragma unroll
    for (int i = 0; i < 2; ++i) { int R, C; stage_rc(tid * 16 + i * 8192, R, C); const int Rb = Epi::PERM ? ((R & ~31) + perm32(R & 31)) : R;
        voffA[i] = (unsigned)(R * K + C) * 2u; voffB[i] = (unsigned)(Rb * K + C) * 2u; }
    const size_t kstep = (size_t)(BK * 2);
    const size_t hstep = (size_t)HALF * K * 2;
    const size_t tstep = 2 * hstep;
    const unsigned ldsw = (unsigned)wid * 1024u;
    const int aoff = lds_byte(wr * 64 + fr, fq * 8), boff = lds_byte(wc * 32 + fr, fq * 8);
#define PG8_SA(b, h) (((b) * 2 + (h)) * HTB)
#define PG8_SB(b, h) ((4 + (b) * 2 + (h)) * HTB)
#define PG8_STAGE(bufoff, gbase, voff) do { _Pragma("unroll") for (int _i = 0; _i < 2; ++_i) \
        __builtin_amdgcn_global_load_lds((const unsigned*)((const char*)(gbase) + (voff)[_i]), (PG8_LAS unsigned*)(lds + (bufoff) + ldsw + _i * 8192), 16, 0, 0); } while (0)
#define PG8_LDA(dst, b, h) do { _Pragma("unroll") for (int m = 0; m < 4; ++m) _Pragma("unroll") for (int k = 0; k < 2; ++k) dst[m][k] = *(const PG8_LAS bf16x8*)(lds + PG8_SA(b, h) + aoff + m * 2048 + k * 1024); } while (0)
#define PG8_LDB(dst, b, h) do { _Pragma("unroll") for (int n = 0; n < 2; ++n) _Pragma("unroll") for (int k = 0; k < 2; ++k) dst[n][k] = *(const PG8_LAS bf16x8*)(lds + PG8_SB(b, h) + boff + n * 2048 + k * 1024); } while (0)
#define PG8_MMA(ai, bj, At, Bt) do { __builtin_amdgcn_s_setprio(1); _Pragma("unroll") for (int m = 0; m < 4; ++m) _Pragma("unroll") for (int n = 0; n < 2; ++n) _Pragma("unroll") for (int k = 0; k < 2; ++k) \
        acc[ai][bj][m][n] = __builtin_amdgcn_mfma_f32_16x16x32_bf16(Bt[n][k], At[m][k], acc[ai][bj][m][n], 0, 0, 0); __builtin_amdgcn_s_setprio(0); } while (0)
#define PG8_WAIT_V(n) asm volatile("s_waitcnt vmcnt(" #n ")" ::: "memory")
#define PG8_WAIT_L(n) asm volatile("s_waitcnt lgkmcnt(" #n ")" ::: "memory")
#define PG8_BAR __builtin_amdgcn_s_barrier()
#define PG8_SCHED __builtin_amdgcn_sched_barrier(0)
    Unit cur, nxt; int ui = 0;
    if (!S.next(0, cur)) return;
    f32x4 acc[2][2][4][2];
#define PG8_ACC_INIT(u) do { if constexpr (Epi::HAS_INIT) { int t3 = tid; asm volatile("" : "+v"(t3)); E.init(acc, (u), wr, wc, t3 & 15, (t3 >> 4) & 3); } else { \
        _Pragma("unroll") for (int a = 0; a < 2; ++a) _Pragma("unroll") for (int b = 0; b < 2; ++b) _Pragma("unroll") for (int m = 0; m < 4; ++m) _Pragma("unroll") for (int n = 0; n < 2; ++n) acc[a][b][m][n] = (f32x4){0.f, 0.f, 0.f, 0.f}; } } while (0)
    PG8_ACC_INIT(cur);
    bf16x8 At[4][2], B0[2][2], B1[2][2];
#define PG8_UA(u) ((const char*)g.A + (size_t)(u).pm * tstep + (size_t)(u).kt0 * kstep)
#define PG8_UB(u) ((const char*)g.Bt + (size_t)(u).pn * tstep + (size_t)(u).kt0 * kstep)
    const char* cA = PG8_UA(cur); const char* cB = PG8_UB(cur);
    S.a_ready(cur);
    if constexpr (SP2) {
        PG8_STAGE(PG8_SB(0, 0), cB, voffB); PG8_STAGE(PG8_SB(0, 1), cB + hstep, voffB); PG8_STAGE(PG8_SA(0, 0), cA, voffA); PG8_STAGE(PG8_SA(0, 1), cA + hstep, voffA);
        if (wr == 1) PG8_BAR;
        PG8_WAIT_V(2); PG8_BAR;
        PG8_STAGE(PG8_SB(1, 0), cB + kstep, voffB); PG8_STAGE(PG8_SA(1, 0), cA + kstep, voffA); PG8_STAGE(PG8_SB(1, 1), cB + hstep + kstep, voffB);
        PG8_WAIT_V(6); PG8_BAR;
    } else {
        PG8_STAGE(PG8_SB(0, 0), cB, voffB); PG8_STAGE(PG8_SA(0, 0), cA, voffA); PG8_STAGE(PG8_SB(0, 1), cB + hstep, voffB); PG8_STAGE(PG8_SA(0, 1), cA + hstep, voffA);
        if (wr == 1) PG8_BAR;
        PG8_WAIT_V(4); PG8_BAR;
        PG8_STAGE(PG8_SB(1, 0), cB + kstep, voffB); PG8_STAGE(PG8_SA(1, 0), cA + kstep, voffA); PG8_STAGE(PG8_SB(1, 1), cB + hstep + kstep, voffB);
        PG8_WAIT_V(6); PG8_BAR;
    }
    for (;;) {
        const bool has_next = S.next(ui + 1, nxt);
        const char* nA = has_next ? PG8_UA(nxt) : cA; const char* nB = has_next ? PG8_UB(nxt) : cB;
        const int unt = cur.nt ? cur.nt : nt;
        for (int t = 0; t < unt; t += 2) {
            const bool last = (t == unt - 2);
            const char* a1 = cA + (size_t)(t + 1) * kstep;
            const char* a2 = last ? nA : cA + (size_t)(t + 2) * kstep; const char* b2 = last ? nB : cB + (size_t)(t + 2) * kstep;
            const char* a3 = a2 + kstep; const char* b3 = b2 + kstep;
            if (last && has_next) S.a_ready(nxt);
            if constexpr (SP2) {
            PG8_LDB(B0, 0, 0); PG8_LDB(B1, 0, 1); PG8_SCHED; PG8_LDA(At, 0, 0); PG8_STAGE(PG8_SA(1, 1), a1 + hstep, voffA);
            PG8_WAIT_V(8); PG8_WAIT_L(0); PG8_BAR; PG8_MMA(0, 0, At, B0); PG8_MMA(0, 1, At, B1); PG8_BAR; PG8_SCHED;
            PG8_LDA(At, 0, 1); PG8_STAGE(PG8_SB(0, 0), b2, voffB); PG8_STAGE(PG8_SB(0, 1), b2 + hstep, voffB); PG8_STAGE(PG8_SA(0, 0), a2, voffA);
            PG8_WAIT_V(8); PG8_WAIT_L(0); PG8_BAR; PG8_MMA(1, 0, At, B0); PG8_MMA(1, 1, At, B1); PG8_BAR; PG8_SCHED;
            PG8_LDB(B0, 1, 0); PG8_LDB(B1, 1, 1); PG8_SCHED; PG8_LDA(At, 1, 0); PG8_STAGE(PG8_SA(0, 1), a2 + hstep, voffA);
            PG8_WAIT_V(8); PG8_WAIT_L(0); PG8_BAR; PG8_MMA(0, 0, At, B0); PG8_MMA(0, 1, At, B1); PG8_BAR; PG8_SCHED;
            PG8_LDA(At, 1, 1); PG8_STAGE(PG8_SB(1, 0), b3, voffB); PG8_STAGE(PG8_SB(1, 1), b3 + hstep, voffB); PG8_STAGE(PG8_SA(1, 0), a3, voffA);
            PG8_WAIT_V(8); PG8_WAIT_L(0); PG8_BAR; PG8_MMA(1, 0, At, B0); PG8_MMA(1, 1, At, B1); PG8_BAR; PG8_SCHED;
            } else {
            PG8_LDB(B0, 0, 0); PG8_SCHED; PG8_LDA(At, 0, 0); PG8_STAGE(PG8_SA(1, 1), a1 + hstep, voffA);
            PG8_WAIT_L(8); PG8_BAR; PG8_WAIT_L(0); PG8_MMA(0, 0, At, B0); PG8_BAR; PG8_SCHED;
            PG8_LDB(B1, 0, 1); PG8_STAGE(PG8_SB(0, 0), b2, voffB);
            PG8_BAR; PG8_WAIT_L(0); PG8_MMA(0, 1, At, B1); PG8_BAR;
            PG8_LDA(At, 0, 1); PG8_STAGE(PG8_SA(0, 0), a2, voffA);
            PG8_BAR; PG8_WAIT_L(0); PG8_MMA(1, 0, At, B0); PG8_BAR; PG8_SCHED;
            PG8_STAGE(PG8_SB(0, 1), b2 + hstep, voffB);
            PG8_WAIT_V(6); PG8_BAR; PG8_MMA(1, 1, At, B1); PG8_BAR;
            PG8_LDB(B0, 1, 0); PG8_SCHED; PG8_LDA(At, 1, 0); PG8_STAGE(PG8_SA(0, 1), a2 + hstep, voffA);
            PG8_WAIT_L(8); PG8_BAR; PG8_WAIT_L(0); PG8_MMA(0, 0, At, B0); PG8_BAR; PG8_SCHED;
            PG8_LDB(B1, 1, 1); PG8_STAGE(PG8_SB(1, 0), b3, voffB);
            PG8_BAR; PG8_WAIT_L(0); PG8_MMA(0, 1, At, B1); PG8_BAR;
            PG8_LDA(At, 1, 1); PG8_STAGE(PG8_SA(1, 0), a3, voffA);
            PG8_BAR; PG8_WAIT_L(0); PG8_MMA(1, 0, At, B0); PG8_BAR; PG8_SCHED;
            PG8_STAGE(PG8_SB(1, 1), b3 + hstep, voffB);
            PG8_WAIT_V(6); PG8_BAR; PG8_MMA(1, 1, At, B1); PG8_BAR;
            }
        }
        if constexpr (ALIGN_EPI) { if (wr == 0) PG8_BAR; }
        if constexpr (!Epi::AFTER_DRAIN) { int t2 = tid; asm volatile("" : "+v"(t2)); const int fr2 = t2 & 15, fq2 = (t2 >> 4) & 3;
            E(acc, cur, wr, wc, fr2, fq2); S.done(cur); }
        if (!has_next) break;
        PG8_ACC_INIT(nxt);
        cur = nxt; cA = nA; cB = nB; ++ui;
        if constexpr (ALIGN_EPI) { if (wr == 1) PG8_BAR; }
    }
    PG8_WAIT_V(0);
    if constexpr (!ALIGN_EPI) { if (wr == 0) PG8_BAR; }
    PG8_BAR;
    if constexpr (Epi::AFTER_DRAIN) { E.fused(acc, cur, wr, wc, fr, fq, lds, wid, lane); S.done(cur); }
#undef PG8_ACC_INIT
#undef PG8_UA
#undef PG8_UB
#undef PG8_SA
#undef PG8_SB
#undef PG8_STAGE
#undef PG8_LDA
#undef PG8_LDB
#undef PG8_MMA
#undef PG8_WAIT_V
#undef PG8_WAIT_L
#undef PG8_BAR
#undef PG8_SCHED
}
}
namespace att {
using bf16x8 = __attribute__((ext_vector_type(8))) short;
using s16x4 = __attribute__((ext_vector_type(4))) short;
using f32x16 = __attribute__((ext_vector_type(16))) float;
using f32x4 = __attribute__((ext_vector_type(4))) float;
using u32x4 = __attribute__((ext_vector_type(4))) unsigned;
using u32x2 = __attribute__((ext_vector_type(2))) unsigned;
typedef unsigned short bf16;
typedef LAS char* lptr;
typedef short v4i16_t __attribute__((ext_vector_type(4)));
#define SBAR() __builtin_amdgcn_sched_barrier(0)
__device__ __forceinline__ int crow(int r, int hi) { return (r & 3) + 8 * (r >> 2) + 4 * hi; }
__device__ __forceinline__ void glds16(const void* gsrc, unsigned lds_dst) { unsigned keep;
    asm volatile("s_mov_b32 %0, m0\n\ts_mov_b32 m0, %2\n\ts_nop 0\n\tglobal_load_lds_dwordx4 %1, off\n\ts_mov_b32 m0, %0" : "=&s"(keep) : "v"(gsrc), "s"(lds_dst) : "memory"); }
__device__ __forceinline__ float max3f(float a, float b, float c) { float r; asm("v_max3_f32 %0, %1, %2, %3" : "=v"(r) : "v"(a), "v"(b), "v"(c)); return r; }
__device__ __forceinline__ float max2f(float a, float b) { float r; asm("v_max_f32_e32 %0, %1, %2" : "=v"(r) : "v"(a), "v"(b)); return r; }
typedef float f32x2_t __attribute__((ext_vector_type(2))); typedef __bf16 bf16x2_t __attribute__((ext_vector_type(2)));
__device__ __forceinline__ unsigned cvtpk_s(float lo, float hi) { f32x2_t v = {lo, hi}; bf16x2_t b = __builtin_convertvector(v, bf16x2_t); return __builtin_bit_cast(unsigned, b); }
__device__ __forceinline__ unsigned short f2bf(float f) { unsigned u = __builtin_bit_cast(unsigned, f); return (unsigned short)((u + 0x7fffu + ((u >> 16) & 1u)) >> 16); }
__device__ __forceinline__ float wave_sum(float v) {
#pragma unroll
    for (int o = 1; o < 64; o <<= 1) v += __shfl_xor(v, o);
    return v;
}
#define WAIT_ALL_BAR() asm volatile("s_waitcnt vmcnt(0) lgkmcnt(0)\n\ts_barrier" ::: "memory")

constexpr int KSLOT = 12288, VSLOT = 8192;
constexpr int L_K = 0, L_V = 2 * KSLOT, L_WS = L_V + 2 * VSLOT, L_OST = L_WS + 8 * 256, L_END = L_OST + 8 * 4096;

__device__ __forceinline__ void qkt6(f32x16& p0, f32x16& p1, const char* Kslot, const bf16x8* qr, int r32, int hi) {
    const char* kb = Kslot + hi * 1024 + r32 * 16;
    const f32x16 z = f32x16{};
#pragma unroll
    for (int d0 = 0; d0 < 6; ++d0) {
        const bf16x8 b0 = *reinterpret_cast<const bf16x8*>(kb + d0 * 2048);
        const bf16x8 b1 = *reinterpret_cast<const bf16x8*>(kb + d0 * 2048 + 512);
        if (d0 == 0) { p0 = __builtin_amdgcn_mfma_f32_32x32x16_bf16(b0, qr[0], z, 0, 0, 0); p1 = __builtin_amdgcn_mfma_f32_32x32x16_bf16(b1, qr[0], z, 0, 0, 0); }
        else { p0 = __builtin_amdgcn_mfma_f32_32x32x16_bf16(b0, qr[d0], p0, 0, 0, 0); p1 = __builtin_amdgcn_mfma_f32_32x32x16_bf16(b1, qr[d0], p1, 0, 0, 0); } }
}
__device__ __forceinline__ float rowmax(const f32x16& p0, const f32x16& p1) {
    float a = max3f(p0[0], p0[1], p1[0]), b = max3f(p0[2], p0[3], p1[1]); a = max3f(a, p1[2], p1[3]);
#pragma unroll
    for (int r = 4; r < 16; r += 4) { a = max3f(a, p0[r], p0[r + 1]); b = max3f(b, p0[r + 2], p0[r + 3]); a = max3f(a, p1[r], p1[r + 1]); b = max3f(b, p1[r + 2], p1[r + 3]); }
    const float m = max2f(a, b);
    auto rr = __builtin_amdgcn_permlane32_swap(__float_as_uint(m), __float_as_uint(m), false, false);
    return max2f(__uint_as_float(rr[0]), __uint_as_float(rr[1]));
}
__device__ __forceinline__ void pv(f32x16* o, int vb, bf16x8 pa0, bf16x8 pa1, bf16x8 pa2, bf16x8 pa3) {
#pragma unroll
    for (int d0 = 0; d0 < 2; ++d0) { s16x4 lo[4], hi[4];
#pragma unroll
        for (int ks = 0; ks < 4; ++ks) {
            asm volatile("ds_read_b64_tr_b16 %0,%1 offset:%c2" : "=&v"(lo[ks]) : "v"(vb), "i"(d0 * 4096 + ks * 1024) : "memory");
            asm volatile("ds_read_b64_tr_b16 %0,%1 offset:%c2" : "=&v"(hi[ks]) : "v"(vb), "i"(d0 * 4096 + ks * 1024 + 512) : "memory"); }
        asm volatile("s_waitcnt lgkmcnt(0)" ::: "memory"); SBAR();
#define PK(k) (bf16x8){lo[k][0], lo[k][1], lo[k][2], lo[k][3], hi[k][0], hi[k][1], hi[k][2], hi[k][3]}
        o[d0] = __builtin_amdgcn_mfma_f32_32x32x16_bf16(pa0, PK(0), o[d0], 0, 0, 0);
        o[d0] = __builtin_amdgcn_mfma_f32_32x32x16_bf16(pa1, PK(1), o[d0], 0, 0, 0);
        o[d0] = __builtin_amdgcn_mfma_f32_32x32x16_bf16(pa2, PK(2), o[d0], 0, 0, 0);
        o[d0] = __builtin_amdgcn_mfma_f32_32x32x16_bf16(pa3, PK(3), o[d0], 0, 0, 0);
#undef PK
    }
}

__device__ __forceinline__ void prompt_unit(int b, int h, int qb, const bf16* Q, const bf16* __restrict__ KN, const bf16* __restrict__ KPE, const bf16* __restrict__ V, bf16* O, char* shm) {
    int tid_ = threadIdx.x; asm volatile("" : "+v"(tid_)); const int tid = tid_, lane = tid & 63, r32 = lane & 31, hi = lane >> 5; const int wid = __builtin_amdgcn_readfirstlane(tid >> 6);
    const long rowbase = (long)b * SEQ; const int q0 = qb * 256;
    const bf16* Qw = Q + (rowbase + q0 + wid * 32) * NQ + h * 96;
    const unsigned lds0 = (unsigned)(uintptr_t)shm;
    float* wsf = (float*)(shm + L_WS) + wid * 64;
    const bf16* ksrc = KN + (rowbase + lane) * 512 + h * 64 + wid * 8;
    const bf16* psrc = KPE + (rowbase + lane) * RD + (wid & 3) * 8;
    const bf16* vsrc = V + (rowbase + 16 * (wid & 3) + (lane >> 2)) * 512 + h * 64 + (wid >> 2) * 32 + (lane & 3) * 8;
    const unsigned kdst = lds0 + L_K + wid * 1024, pdst = lds0 + L_K + (8 + (wid & 3)) * 1024, vdst = lds0 + L_V + wid * 1024;
#define DMA_KV(t, sl) do { glds16(ksrc + (long)(t) * 64 * 512, (unsigned)__builtin_amdgcn_readfirstlane(kdst + (sl) * KSLOT)); \
        if (wid < 4) glds16(psrc + (long)(t) * 64 * RD, (unsigned)__builtin_amdgcn_readfirstlane(pdst + (sl) * KSLOT)); \
        glds16(vsrc + (long)(t) * 64 * 512, (unsigned)__builtin_amdgcn_readfirstlane(vdst + (sl) * VSLOT)); } while (0)
    const int vb0 = (int)(lds0 + L_V) + ((lane >> 4) & 1) * 32 + (lane & 3) * 8 + (4 * hi + ((lane & 15) >> 2)) * 64;
    const char* Kbase = shm + L_K;
    const int NT = 4 * qb + 4, nvis = 4 * qb + (wid >> 1) + 1;
    DMA_KV(0, 0);
    bf16x8 qr[6];
#pragma unroll
    for (int d0 = 0; d0 < 6; ++d0) qr[d0] = *reinterpret_cast<const bf16x8*>(&Qw[(long)r32 * NQ + d0 * 16 + hi * 8]);
    float m = -1e30f, l = 0.f; f32x16 o[2]; o[0] = f32x16{}; o[1] = f32x16{};
    WAIT_ALL_BAR();
    for (int t = 0; t < NT; ++t) {
        const int cur = t & 1;
        if (t + 1 < NT) DMA_KV(t + 1, cur ^ 1);
        if (t < nvis) {
            f32x16 p0, p1;
            qkt6(p0, p1, Kbase + cur * KSLOT, qr, r32, hi);
            const float rm = rowmax(p0, p1);
            const float mn = __builtin_fmaxf(m, rm); const float f = __builtin_amdgcn_exp2f(m - mn); m = mn;
            float sacc = 0.f;
#pragma unroll
            for (int r = 0; r < 16; ++r) { p0[r] = __builtin_amdgcn_exp2f(p0[r] - mn); p1[r] = __builtin_amdgcn_exp2f(p1[r] - mn); sacc += p0[r] + p1[r]; }
            l = l * f + sacc;
            if (__any(f != 1.0f)) {
                if (hi == 0) wsf[r32] = f;
                asm volatile("s_waitcnt lgkmcnt(0)" ::: "memory");
#pragma unroll
                for (int r = 0; r < 16; ++r) { const float fr_ = wsf[crow(r, hi)]; o[0][r] *= fr_; o[1][r] *= fr_; }
            }
            u32x4 pw0 = {cvtpk_s(p0[0], p0[1]), cvtpk_s(p0[2], p0[3]), cvtpk_s(p0[4], p0[5]), cvtpk_s(p0[6], p0[7])};
            u32x4 pw1 = {cvtpk_s(p0[8], p0[9]), cvtpk_s(p0[10], p0[11]), cvtpk_s(p0[12], p0[13]), cvtpk_s(p0[14], p0[15])};
            u32x4 pw2 = {cvtpk_s(p1[0], p1[1]), cvtpk_s(p1[2], p1[3]), cvtpk_s(p1[4], p1[5]), cvtpk_s(p1[6], p1[7])};
            u32x4 pw3 = {cvtpk_s(p1[8], p1[9]), cvtpk_s(p1[10], p1[11]), cvtpk_s(p1[12], p1[13]), cvtpk_s(p1[14], p1[15])};
            pv(o, vb0 + cur * VSLOT, __builtin_bit_cast(bf16x8, pw0), __builtin_bit_cast(bf16x8, pw1), __builtin_bit_cast(bf16x8, pw2), __builtin_bit_cast(bf16x8, pw3));
        }
        WAIT_ALL_BAR();
    }
    { auto rr = __builtin_amdgcn_permlane32_swap(__float_as_uint(l), __float_as_uint(l), false, false); l = __uint_as_float(rr[0]) + __uint_as_float(rr[1]); }
    if (hi == 0) wsf[32 + r32] = l;
    asm volatile("s_waitcnt lgkmcnt(0)" ::: "memory");
    float rli[16];
#pragma unroll
    for (int r = 0; r < 16; ++r) rli[r] = __builtin_amdgcn_rcpf(wsf[32 + crow(r, hi)]);
    bf16* Ow = O + (rowbase + q0 + wid * 32) * 512 + h * 64;
    { bf16* stg = (bf16*)(shm + L_OST) + wid * 2048;
#pragma unroll
        for (int r = 0; r < 16; ++r) { const int orow = crow(r, hi);
#pragma unroll
            for (int d0 = 0; d0 < 2; ++d0) stg[orow * 64 + d0 * 32 + r32] = f2bf(o[d0][r] * rli[r]); }
        asm volatile("s_waitcnt lgkmcnt(0)" ::: "memory");
#pragma unroll
        for (int i = 0; i < 4; ++i) { const int row = i * 8 + (lane >> 3), ch = lane & 7; const u32x4 v = *(const u32x4*)(stg + row * 64 + ch * 8); *(u32x4*)(Ow + (long)row * 512 + ch * 8) = v; } }
    asm volatile("s_waitcnt lgkmcnt(0)\n\ts_barrier" ::: "memory");
#undef DMA_KV
}

constexpr int DQS = 592, D_QL = 0, D_KT = 128 * DQS, D_END = D_KT + 64 * DQS;
__device__ __forceinline__ void decode_unit(int b, int sp, const bf16* Q, const bf16* __restrict__ WUKn, const float* __restrict__ cache_kv, const float* __restrict__ cache_kr,
                                            const bf16* __restrict__ CKVN, const bf16* __restrict__ KPE, float* PART, float* ML, lptr shm) {
    int tid_ = threadIdx.x; asm volatile("" : "+v"(tid_)); const int tid = tid_, lane = tid & 63, fr = lane & 15, g = lane >> 4; const int w = __builtin_amdgcn_readfirstlane(tid >> 6);
    const lptr QLp = shm + D_QL, KTp = shm + D_KT;
    const float* kc = cache_kv + ((size_t)b * PAST + (size_t)sp * 256) * KVL; const float* kr = cache_kr + ((size_t)b * PAST + (size_t)sp * 256) * RD;
    f32x4 pre[9];
#define DEC_LOAD(t) do { const float* kc_ = kc + (size_t)(t) * 64 * KVL + tid * 4; _Pragma("unroll") for (int i_ = 0; i_ < 8; ++i_) pre[i_] = *(const f32x4*)(kc_ + i_ * 2048); \
        pre[8] = *(const f32x4*)(kr + (size_t)(t) * 64 * RD + tid * 4); } while (0)
#define DEC_STORE() do { _Pragma("unroll") for (int i_ = 0; i_ < 8; ++i_) { u32x2 w_; w_.x = cvtpk_s(pre[i_][0], pre[i_][1]); w_.y = cvtpk_s(pre[i_][2], pre[i_][3]); \
            *(LAS u32x2*)(KTp + ((tid >> 6) + 8 * i_) * DQS + (tid & 63) * 8) = w_; } \
        { const int a_ = tid & 7; u32x2 w_; w_.x = cvtpk_s(pre[8][0], pre[8][1]); w_.y = cvtpk_s(pre[8][2], pre[8][3]); \
            *(LAS u32x2*)(KTp + (tid >> 3) * DQS + 512 + 16 * (a_ & 3) + 8 * (a_ >> 2)) = w_; } } while (0)
    DEC_LOAD(0);
    __syncthreads();
    const bf16* qrow = Q + ((size_t)TP + b * SSEQ + fr) * NQ + w * 96;
    *(LAS u32x4*)(QLp + (16 * w + fr) * DQS + 512 + 16 * g) = *(const u32x4*)(qrow + 64 + 8 * g);
    { const bf16x8 qf0 = *(const bf16x8*)(qrow + 8 * g), qf1 = *(const bf16x8*)(qrow + 32 + 8 * g);
#pragma unroll 4
        for (int cb = 0; cb < 16; ++cb) { const bf16* wr_ = WUKn + (size_t)(16 * cb + fr) * 512 + w * 64 + 8 * g;
            f32x4 a = {0.f, 0.f, 0.f, 0.f};
            a = __builtin_amdgcn_mfma_f32_16x16x32_bf16(*(const bf16x8*)wr_, qf0, a, 0, 0, 0);
            a = __builtin_amdgcn_mfma_f32_16x16x32_bf16(*(const bf16x8*)(wr_ + 32), qf1, a, 0, 0, 0);
            u32x2 w_; w_.x = cvtpk_s(a[0], a[1]); w_.y = cvtpk_s(a[2], a[3]);
            *(LAS u32x2*)(QLp + (16 * w + fr) * DQS + (16 * cb + 4 * g) * 2) = w_; } }
    DEC_STORE();
    __syncthreads();
    const int NT = 4 + (sp == 15 ? 1 : 0);
    float m = -1e30f, l = 0.f; f32x4 o[16];
#pragma unroll
    for (int cb = 0; cb < 16; ++cb) o[cb] = (f32x4){0.f, 0.f, 0.f, 0.f};
    for (int t = 0; t < NT; ++t) {
        if (t + 1 < 4) DEC_LOAD(t + 1);
        f32x4 s[4];
#pragma unroll
        for (int kb = 0; kb < 4; ++kb) s[kb] = (f32x4){0.f, 0.f, 0.f, 0.f};
#pragma unroll
        for (int ds = 0; ds < 9; ++ds) { const bf16x8 qf = *(const LAS bf16x8*)(QLp + (16 * w + fr) * DQS + (32 * ds + 8 * g) * 2);
#pragma unroll
            for (int kb = 0; kb < 4; ++kb) { const bf16x8 kf = *(const LAS bf16x8*)(KTp + (16 * kb + fr) * DQS + (32 * ds + 8 * g) * 2);
                s[kb] = __builtin_amdgcn_mfma_f32_16x16x32_bf16(kf, qf, s[kb], 0, 0, 0); } }
        if (t == 4) { s[1] = (f32x4){-1e30f, -1e30f, -1e30f, -1e30f}; s[2] = s[1]; s[3] = s[1]; }
        float rm = __builtin_fmaxf(__builtin_fmaxf(s[0][0], s[0][1]), __builtin_fmaxf(s[0][2], s[0][3]));
#pragma unroll
        for (int kb = 1; kb < 4; ++kb) rm = __builtin_fmaxf(rm, __builtin_fmaxf(__builtin_fmaxf(s[kb][0], s[kb][1]), __builtin_fmaxf(s[kb][2], s[kb][3])));
        rm = __builtin_fmaxf(rm, __shfl_xor(rm, 16)); rm = __builtin_fmaxf(rm, __shfl_xor(rm, 32));
        const float mn = __builtin_fmaxf(m, rm), f = __builtin_amdgcn_exp2f(m - mn); m = mn;
        float ls = 0.f;
#pragma unroll
        for (int kb = 0; kb < 4; ++kb)
#pragma unroll
            for (int i = 0; i < 4; ++i) { s[kb][i] = __builtin_amdgcn_exp2f(s[kb][i] - mn); ls += s[kb][i]; }
        l = l * f + ls;
#pragma unroll
        for (int cb = 0; cb < 16; ++cb) o[cb] *= f;
        u32x4 pw[2];
#pragma unroll
        for (int s2 = 0; s2 < 2; ++s2) pw[s2] = (u32x4){cvtpk_s(s[2 * s2][0], s[2 * s2][1]), cvtpk_s(s[2 * s2][2], s[2 * s2][3]), cvtpk_s(s[2 * s2 + 1][0], s[2 * s2 + 1][1]), cvtpk_s(s[2 * s2 + 1][2], s[2 * s2 + 1][3])};
#pragma unroll
        for (int cb = 0; cb < 16; ++cb)
#pragma unroll
            for (int s2 = 0; s2 < 2; ++s2) { const lptr va = KTp + (32 * s2 + 4 * g + (fr >> 2)) * DQS + (16 * cb + 4 * (fr & 3)) * 2;
                const s16x4 lo = __builtin_bit_cast(s16x4, __builtin_amdgcn_ds_read_tr16_b64_v4i16((LAS v4i16_t*)va));
                const s16x4 hh = __builtin_bit_cast(s16x4, __builtin_amdgcn_ds_read_tr16_b64_v4i16((LAS v4i16_t*)(va + 16 * DQS)));
                const bf16x8 vf = {lo[0], lo[1], lo[2], lo[3], hh[0], hh[1], hh[2], hh[3]};
                o[cb] = __builtin_amdgcn_mfma_f32_16x16x32_bf16(vf, __builtin_bit_cast(bf16x8, pw[s2]), o[cb], 0, 0, 0); }
        __syncthreads();
        if (t + 1 < NT) {
            if (t + 1 < 4) { DEC_STORE(); }
            else {
                for (int idx = tid; idx < 16 * 36; idx += 512) { const int key = idx / 36, ch = idx - key * 36; const size_t row = (size_t)TP + b * SSEQ + key;
                    const u32x4 v = (ch < 32) ? *(const u32x4*)(CKVN + row * KVL + ch * 8) : *(const u32x4*)(KPE + row * RD + (ch - 32) * 8);
                    *(LAS u32x4*)(KTp + key * DQS + ch * 16) = v; }
                for (int idx = tid; idx < 48 * 37; idx += 512) { const int key = 16 + idx / 37, ch = idx % 37; *(LAS u32x4*)(KTp + key * DQS + ch * 16) = (u32x4){0u, 0u, 0u, 0u}; }
            }
        }
        __syncthreads();
    }
    l += __shfl_xor(l, 16); l += __shfl_xor(l, 32);
    const size_t prow = ((size_t)(b * 16 + sp) * 128 + 16 * w + fr);
#pragma unroll
    for (int cb = 0; cb < 16; ++cb) *(f32x4*)(PART + prow * 256 + 16 * cb + 4 * g) = o[cb];
    if (g == 0) { ML[prow * 2] = m; ML[prow * 2 + 1] = l; }
#undef DEC_LOAD
#undef DEC_STORE
}

__device__ __forceinline__ void combine_item(int b, int tok, const float* PART, const float* ML, const bf16* __restrict__ Wkv_t, bf16* OMLA, lptr shm) {
    int tid_ = threadIdx.x; asm volatile("" : "+v"(tid_)); const int tid = tid_, lane = tid & 63; const int h = __builtin_amdgcn_readfirstlane(tid >> 6);
    LAS float* OL = (LAS float*)shm;
    float mv[16], lv[16], M = -1e30f;
#pragma unroll
    for (int s = 0; s < 16; ++s) { const size_t pr = ((size_t)(b * 16 + s) * 128 + 16 * h + tok); mv[s] = ML[pr * 2]; lv[s] = ML[pr * 2 + 1]; M = __builtin_fmaxf(M, mv[s]); }
    f32x4 acc = {0.f, 0.f, 0.f, 0.f}; float L = 0.f;
#pragma unroll
    for (int s = 0; s < 16; ++s) { const size_t pr = ((size_t)(b * 16 + s) * 128 + 16 * h + tok); const float wgt = __builtin_amdgcn_exp2f(mv[s] - M);
        L += wgt * lv[s]; acc += *(const f32x4*)(PART + pr * 256 + 4 * lane) * wgt; }
    const float rl = 1.0f / L;
    __syncthreads();
    *(LAS f32x4*)(OL + h * 256 + 4 * lane) = acc * rl;
    __syncthreads();
    const bf16* wrow = Wkv_t + (size_t)(512 + h * 64 + lane) * KVL;
    float sum = 0.f;
#pragma unroll 4
    for (int c8 = 0; c8 < 32; ++c8) { const u32x4 wv = *(const u32x4*)(wrow + c8 * 8); const f32x4 o0 = *(const LAS f32x4*)(OL + h * 256 + c8 * 8), o1 = *(const LAS f32x4*)(OL + h * 256 + c8 * 8 + 4);
        sum += o0[0] * __uint_as_float(wv.x << 16) + o0[1] * __uint_as_float(wv.x & 0xffff0000u) + o0[2] * __uint_as_float(wv.y << 16) + o0[3] * __uint_as_float(wv.y & 0xffff0000u)
             + o1[0] * __uint_as_float(wv.z << 16) + o1[1] * __uint_as_float(wv.z & 0xffff0000u) + o1[2] * __uint_as_float(wv.w << 16) + o1[3] * __uint_as_float(wv.w & 0xffff0000u); }
    OMLA[((size_t)TP + b * SSEQ + tok) * 512 + h * 64 + lane] = f2bf(sum);
}

constexpr int M_UH = 0, M_WDW = 62 * 1024, M_END = M_WDW + 31 * 2048;
template <int NR> __device__ __forceinline__ void mix_rows(lptr UH, const LAS float* WDW, int lrow0, size_t grow0, const float* bdw, const float* gcn, const float* bcn,
                                                           const bf16* __restrict__ OMLA, bf16* MIX, int lane) {
    float acc[NR][8];
#pragma unroll
    for (int r = 0; r < NR; ++r)
#pragma unroll
        for (int e = 0; e < 8; ++e) acc[r][e] = bdw[e];
#pragma unroll 4
    for (int j = 0; j < CW; ++j) {
        const f32x4 w0 = *(const LAS f32x4*)(WDW + j * 512 + 8 * lane), w1 = *(const LAS f32x4*)(WDW + j * 512 + 8 * lane + 4);
#pragma unroll
        for (int r = 0; r < NR; ++r) { const u32x4 uv = *(const LAS u32x4*)(UH + (lrow0 + r + j) * 1024 + 16 * lane);
            acc[r][0] += __uint_as_float(uv.x << 16) * w0[0]; acc[r][1] += __uint_as_float(uv.x & 0xffff0000u) * w0[1];
            acc[r][2] += __uint_as_float(uv.y << 16) * w0[2]; acc[r][3] += __uint_as_float(uv.y & 0xffff0000u) * w0[3];
            acc[r][4] += __uint_as_float(uv.z << 16) * w1[0]; acc[r][5] += __uint_as_float(uv.z & 0xffff0000u) * w1[1];
            acc[r][6] += __uint_as_float(uv.w << 16) * w1[2]; acc[r][7] += __uint_as_float(uv.w & 0xffff0000u) * w1[3]; }
    }
#pragma unroll
    for (int r = 0; r < NR; ++r) {
        float s = 0.f;
#pragma unroll
        for (int e = 0; e < 8; ++e) s += acc[r][e];
        const float mu = wave_sum(s) * (1.0f / CC);
        float q = 0.f;
#pragma unroll
        for (int e = 0; e < 8; ++e) { acc[r][e] -= mu; q += acc[r][e] * acc[r][e]; }
        const float rs = rsqrtf(wave_sum(q) * (1.0f / CC) + EPS);
        float q2 = 0.f;
#pragma unroll
        for (int e = 0; e < 8; ++e) { const float ln = acc[r][e] * rs * gcn[e] + bcn[e]; const float co = ln * __builtin_amdgcn_rcpf(1.f + __builtin_amdgcn_exp2f(-1.4426950408889634f * ln)); acc[r][e] = co; q2 += co * co; }
        const float r2 = rsqrtf(wave_sum(q2) * (1.0f / CC) + EPS);
        const size_t row = grow0 + r;
        u32x4 ov; ov.x = cvtpk_s(acc[r][0] * r2, acc[r][1] * r2); ov.y = cvtpk_s(acc[r][2] * r2, acc[r][3] * r2); ov.z = cvtpk_s(acc[r][4] * r2, acc[r][5] * r2); ov.w = cvtpk_s(acc[r][6] * r2, acc[r][7] * r2);
        *(u32x4*)(MIX + row * DM + 512 + 8 * lane) = ov;
        const u32x4 om = *(const u32x4*)(OMLA + row * 512 + 8 * lane);
        float x[8] = {__uint_as_float(om.x << 16), __uint_as_float(om.x & 0xffff0000u), __uint_as_float(om.y << 16), __uint_as_float(om.y & 0xffff0000u),
                      __uint_as_float(om.z << 16), __uint_as_float(om.z & 0xffff0000u), __uint_as_float(om.w << 16), __uint_as_float(om.w & 0xffff0000u)};
        float q3 = 0.f;
#pragma unroll
        for (int e = 0; e < 8; ++e) q3 += x[e] * x[e];
        const float r3 = rsqrtf(wave_sum(q3) * (1.0f / 512.0f) + EPS);
        u32x4 o2; o2.x = cvtpk_s(x[0] * r3, x[1] * r3); o2.y = cvtpk_s(x[2] * r3, x[3] * r3); o2.z = cvtpk_s(x[4] * r3, x[5] * r3); o2.w = cvtpk_s(x[6] * r3, x[7] * r3);
        *(u32x4*)(MIX + row * DM + 8 * lane) = o2;
    }
}
#undef SBAR
}

constexpr int NWAVES = 8;
#ifndef MK_N_LAUNCHES
#define MK_N_LAUNCHES 1
#endif
constexpr int NPHASE = 11;
#ifndef MK_DUP
#define MK_DUP 0
#endif
constexpr int N_LAUNCHES = MK_N_LAUNCHES;

constexpr size_t MiB = 1u << 20;
constexpr size_t WS_CTL = 0, CTL_ZERO_BYTES = 512 * 1024;
constexpr size_t WS_W1 = 1 * MiB, WS_WQ = 5 * MiB, WS_WKV = 6 * MiB, WS_WO = 7 * MiB, WS_WGU = 9 * MiB, WS_WD = 20 * MiB, WS_WUKN = 25 * MiB + 512 * 1024, WS_ROPE = 26 * MiB;
constexpr size_t WS_XN = 27 * MiB, WS_MIX = WS_XN, WS_CQ = 60 * MiB, WS_CKVN = 73 * MiB, WS_KPE = 82 * MiB, WS_U = 84 * MiB, WS_Q = 101 * MiB, WS_ACT = 27 * MiB;
constexpr size_t WS_H2 = 126 * MiB;
constexpr size_t WS_SLAB6 = 208 * MiB, WS_SLAB8 = 212 * MiB;
constexpr int MT6 = 4, MT8 = 4;
constexpr size_t WS_KN = 126 * MiB, WS_V = 142 * MiB, WS_OMLA = 158 * MiB, WS_HB = 175 * MiB, WS_PART = 208 * MiB, WS_ML = 240 * MiB, WS_END = 241 * MiB;
static_assert(WS_W1 + (size_t)N1 * DM * 2 <= WS_WQ && WS_WQ + (size_t)NQ * QL * 2 <= WS_WKV && WS_WKV + (size_t)NKV * KVL * 2 <= WS_WO && WS_WO + (size_t)DM * DM * 2 <= WS_WGU &&
              WS_WGU + (size_t)NGU * DM * 2 <= WS_WD && WS_WD + (size_t)DM * DFF * 2 <= WS_WUKN && WS_WUKN + (size_t)KVL * 512 * 2 <= WS_ROPE && WS_ROPE + (size_t)NPOS * 16 * 8 <= WS_XN, "weight map");
static_assert(WS_XN + (size_t)T * DM * 2 <= WS_CQ && WS_CQ + (size_t)T * QL * 2 <= WS_CKVN && WS_CKVN + (size_t)T * KVL * 2 <= WS_KPE && WS_KPE + (size_t)T * RD * 2 <= WS_U &&
              WS_U + (size_t)T * CC * 2 <= WS_Q && WS_Q + (size_t)T * NQ * 2 <= WS_KN && WS_ACT + (size_t)T * DFF * 2 <= WS_KN && WS_KN + (size_t)TP * 512 * 2 <= WS_V &&
              WS_V + (size_t)TP * 512 * 2 <= WS_OMLA && WS_OMLA + (size_t)T * 512 * 2 <= WS_HB && WS_HB + (size_t)T * DM * 2 <= WS_PART && WS_PART + (size_t)256 * 128 * 256 * 4 <= WS_ML &&
              WS_ML + (size_t)256 * 128 * 2 * 4 <= WS_END, "activation map");
constexpr int CW_TMO = 0, CW_CODE = 1, CW_BAR = 4096, CW_CNT6 = 8192, CW_SSQ_Q = 16384, CW_SSQ_H = CW_SSQ_Q + T;
static_assert((size_t)(CW_SSQ_H + T) * 4 <= CTL_ZERO_BYTES, "CTL words inside the memset region");
constexpr int RING_OFF = 0, RING_BYTES = 131072, EX_OFF = RING_BYTES, LDSCTL_OFF = EX_OFF + 4096, MISC_OFF = LDSCTL_OFF + 320, LDS_BYTES = 147456;
static_assert(MISC_OFF + 128 <= LDS_BYTES && att::L_END <= RING_BYTES && att::D_END <= RING_BYTES && att::M_END <= RING_BYTES, "LDS map");

typedef unsigned short bf16;
typedef unsigned v4u __attribute__((ext_vector_type(4)));
typedef float f32x4 __attribute__((ext_vector_type(4)));
typedef GAS unsigned gu32;
#define RLX_AGENT __ATOMIC_RELAXED, __HIP_MEMORY_SCOPE_AGENT
#define LDS_WAIT() asm volatile("s_waitcnt lgkmcnt(0)" ::: "memory")
#define VM_WAIT() asm volatile("s_waitcnt vmcnt(0)" ::: "memory")
__device__ __forceinline__ unsigned f2bf(float f) { unsigned u = __builtin_bit_cast(unsigned, f); return (u + 0x7fffu + ((u >> 16) & 1u)) >> 16; }
__device__ __forceinline__ unsigned pk2(float lo, float hi) { return f2bf(lo) | (f2bf(hi) << 16); }

#define XB_TMO      128
#define XB_XCNT(j)  (256  + 64 * (j))
#define XB_XSUB(j)  (1280 + 64 * (j))
#define XB_XGEN(j)  (2304 + 64 * (j))
#define XB_TOP      3328
#define XB_TOPGEN   3392
#define XCD_BAR_WORDS 3456
#define XB_SPIN_CAP (1u << 18)

__device__ __forceinline__ unsigned xb_ld(unsigned* p)              { return __hip_atomic_load(p, __ATOMIC_RELAXED, __HIP_MEMORY_SCOPE_AGENT); }
__device__ __forceinline__ unsigned xb_add(unsigned* p, unsigned v) { return __hip_atomic_fetch_add(p, v, __ATOMIC_RELAXED, __HIP_MEMORY_SCOPE_AGENT); }
__device__ __forceinline__ unsigned xb_xcc_id() { return (unsigned)__builtin_amdgcn_s_getreg((3 << 11) | 20) & 0xFu; }
#define XB_SPIN(cond, bar) do { unsigned _sp = 0; while (cond) { __builtin_amdgcn_s_sleep(1); \
    if ((++_sp & 255u) == 0u) { if (xb_ld(&(bar)[XB_TMO])) break; if (_sp > XB_SPIN_CAP) { atomicAdd(&(bar)[XB_TMO], 1u); break; } } } } while (0)

struct XcdBarrier {
    unsigned* bar; unsigned x;
    volatile LAS unsigned* st;
};

__device__ __forceinline__ XcdBarrier xcd_barrier_post(unsigned* bar, volatile LAS unsigned* st) {
    XcdBarrier b; b.bar = bar; b.x = xb_xcc_id(); b.st = st;
    if (threadIdx.x == 0) (void)xb_add(&bar[XB_XCNT(b.x)], 1u);
    return b;
}
__device__ __forceinline__ void xcd_barrier_complete(unsigned* bar, unsigned x, unsigned& nloc, unsigned& nx) {
    const unsigned G = gridDim.x * gridDim.y * gridDim.z;
    unsigned sum, cnt, mine, sp = 0u;
    for (;;) {
        sum = 0u; cnt = 0u; mine = 0u;
#pragma unroll
        for (unsigned j = 0; j < 16; ++j) { const unsigned c = xb_ld(&bar[XB_XCNT(j)]); sum += c; cnt += (c > 0u) ? 1u : 0u; mine = (j == x) ? c : mine; }
        if (sum == G) break;
        __builtin_amdgcn_s_sleep(1);
        if ((++sp & 255u) == 0u) { if (xb_ld(&bar[XB_TMO])) break; if (sp > XB_SPIN_CAP) { atomicAdd(&bar[XB_TMO], 1u); break; } }
    }
    nloc = mine > 0u ? mine : 1u; nx = cnt > 0u ? cnt : 1u;
}

__device__ __forceinline__ void xcd_barrier(const XcdBarrier& b) {
    asm volatile("s_waitcnt vmcnt(0)" ::: "memory");
    __syncthreads();
    if (threadIdx.x == 0) {
        unsigned* bar = b.bar;
        __builtin_amdgcn_s_waitcnt(0);
        unsigned nloc = b.st[0], nx = b.st[1];
        if (nloc == 0u) { xcd_barrier_complete(bar, b.x, nloc, nx); b.st[0] = nloc; b.st[1] = nx; }
        const unsigned old = xb_add(&bar[XB_XSUB(b.x)], 1u);
        const unsigned gen = old / nloc;
        if (old + 1u == (gen + 1u) * nloc) {
            __builtin_amdgcn_fence(__ATOMIC_RELEASE, "agent");
            asm volatile("s_waitcnt vmcnt(0)" ::: "memory");
            const unsigned og = xb_add(&bar[XB_TOP], 1u);
            const unsigned tg = og / nx;
            if (og + 1u == (tg + 1u) * nx) xb_add(&bar[XB_TOPGEN], 1u);
            else XB_SPIN(xb_ld(&bar[XB_TOPGEN]) == tg, bar);
            __builtin_amdgcn_fence(__ATOMIC_ACQUIRE, "agent");
            xb_add(&bar[XB_XGEN(b.x)], 1u);
            asm volatile("s_waitcnt vmcnt(0)" ::: "memory");
        } else {
            XB_SPIN(xb_ld(&bar[XB_XGEN(b.x)]) == gen, bar);
            __builtin_amdgcn_fence(__ATOMIC_ACQUIRE, "agent");
            asm volatile("s_waitcnt vmcnt(0)" ::: "memory");
        }
    }
    __syncthreads();
}


template <class Src> __device__ __forceinline__ void p0_transpose_item(const Src& S, int K, bf16* WT, LAS float* scr, int item, int lane) {
    const int nblk = Src::N / 32, kb = item / nblk, nb = item % nblk, k0 = 64 * kb, n0 = 32 * nb;
#pragma unroll 8
    for (int i = 0; i < 32; ++i) { const int kk = 2 * i + (lane >> 5); scr[kk * 33 + (lane & 31)] = S.load(k0 + kk, n0 + (lane & 31)); }
    LDS_WAIT(); asm volatile("" ::: "memory");
    const int c = lane & 7;
#pragma unroll
    for (int j = 0; j < 4; ++j) { const int n = (lane >> 3) + 8 * j; const LAS float* s = scr + (8 * c) * 33 + n;
        v4u o; o.x = pk2(s[0 * 33], s[1 * 33]); o.y = pk2(s[2 * 33], s[3 * 33]); o.z = pk2(s[4 * 33], s[5 * 33]); o.w = pk2(s[6 * 33], s[7 * 33]);
        *(GAS v4u*)(WT + (size_t)(n0 + n) * K + k0 + 8 * c) = o; }
    LDS_WAIT(); asm volatile("" ::: "memory");
}
struct SrcW1 { static constexpr int N = N1; const float* w;
    __device__ __forceinline__ float load(int k, int n) const { int col;
        if (n < 256) col = QL + n;
        else if (n < 640) col = n - 256;
        else if (n < 672) { const int p = n - 640; col = QL + KVL + ((p >> 2) & 1) * 16 + 4 * (p >> 3) + (p & 3); }
        else if (n < 768) return 0.f;
        else { const int q = (n - 768) & 255, t = (n - 768) >> 8; col = QL + KVL + RD + ((q >> 7) ? CC : 0) + 128 * t + (q & 127); }
        return w[(size_t)k * INW + col]; } };
struct SrcWq { static constexpr int N = NQ; const float* w; const float* g;
    __device__ __forceinline__ float load(int k, int n) const { const int h = n / 96, r = n - h * 96; int col = h * 96 + r;
        if (r >= 64) { const int p = r - 64; col = h * 96 + 64 + ((p >> 2) & 1) * 16 + 4 * (p >> 3) + (p & 3); }
        return w[(size_t)k * NQ + col] * g[k]; } };
struct SrcWkv { static constexpr int N = NKV; const float* w;
    __device__ __forceinline__ float load(int k, int n) const { return w[(size_t)k * 512 + (n & 511)]; } };
struct SrcWo { static constexpr int N = DM; const float* w; const float* g;
    __device__ __forceinline__ float load(int k, int n) const { return w[(size_t)k * DM + n] * g[k & 511]; } };
struct SrcWgu { static constexpr int N = NGU; const float* w; const float* ln;
    __device__ __forceinline__ float load(int k, int n) const { const int t = n >> 8, q = n & 255, j = 128 * t + (q & 127); return w[(size_t)k * DFF + j] * ln[k]; } };
struct SrcWd { static constexpr int N = DM; const float* w;
    __device__ __forceinline__ float load(int k, int n) const { return w[(size_t)k * DM + n]; } };

__device__ __forceinline__ void rms_row(const float* xrow, const float* g, bf16* out_bf, float* out_f32, int lane, const float* slab = nullptr, int nslab = 0, const bf16* hbrow = nullptr) {
    const GAS f32x4* xr = (const GAS f32x4*)xrow + lane; const GAS f32x4* gr = (const GAS f32x4*)g + lane;
    f32x4 v[4]; float s = 0.f;
    if (hbrow) {
#pragma unroll
        for (int j = 0; j < 4; ++j) { const unsigned long long h = ((const GAS unsigned long long*)hbrow + lane)[64 * j]; const unsigned lo = (unsigned)h, hi = (unsigned)(h >> 32);
            v[j] = (f32x4){__uint_as_float(lo << 16), __uint_as_float(lo & 0xffff0000u), __uint_as_float(hi << 16), __uint_as_float(hi & 0xffff0000u)}; }
    } else {
#pragma unroll
        for (int j = 0; j < 4; ++j) v[j] = xr[64 * j];
    }
    if (slab) for (int sl = 0; sl < nslab; ++sl) { const GAS f32x4* sr = (const GAS f32x4*)(slab + (size_t)sl * 256 * DM) + lane;
#pragma unroll
        for (int j = 0; j < 4; ++j) v[j] += sr[64 * j]; }
#pragma unroll
    for (int j = 0; j < 4; ++j) s += (v[j].x * v[j].x + v[j].y * v[j].y) + (v[j].z * v[j].z + v[j].w * v[j].w);
    const float r = rsqrtf(att::wave_sum(s) * (1.0f / DM) + EPS);
#pragma unroll
    for (int j = 0; j < 4; ++j) { const f32x4 o = v[j] * r * gr[64 * j];
        if (out_bf) { GAS unsigned long long* o8 = (GAS unsigned long long*)out_bf + lane; o8[64 * j] = (unsigned long long)pk2(o.x, o.y) | ((unsigned long long)pk2(o.z, o.w) << 32); }
        else ((GAS f32x4*)out_f32 + lane)[64 * j] = o; }
}

struct Args { const float* in[24]; float* out; unsigned char* ws; int ph_lo, ph_hi; };
__global__ void __launch_bounds__(NWAVES * 64, 2) mk_fwd(Args args) {
    extern __shared__ __attribute__((aligned(16))) unsigned char lds[];
    LAS unsigned char* const ldsp = (LAS unsigned char*)lds;
    volatile LAS unsigned* const MISC = (volatile LAS unsigned*)(ldsp + MISC_OFF);
    const int tid0 = threadIdx.x, wave = __builtin_amdgcn_readfirstlane(tid0 >> 6);
#define PHASE_IDS() int tid = tid0; asm volatile("" : "+v"(tid)); const int lane = tid & 63; const int gtid = (int)blockIdx.x * (NWAVES * 64) + tid; (void)lane; (void)gtid
    const int G = gridDim.x; const int vcu = (G % 8 == 0) ? ((int)blockIdx.x % 8) * (G / 8) + (int)blockIdx.x / 8 : (int)blockIdx.x;
    unsigned char* const ws = args.ws; float* const out = args.out;
    gu32* const ctl = (gu32*)(ws + WS_CTL);
    const float *x_p = args.in[0], *x_s = args.in[1], *cache_kv = args.in[2], *cache_kr = args.in[3], *st_conv = args.in[4], *ln_mix = args.in[5], *w_in = args.in[6], *g_q = args.in[7],
                *w_uq = args.in[8], *g_kv = args.in[9], *w_uk = args.in[10], *w_uv = args.in[11], *w_dw = args.in[12], *b_dw = args.in[13], *g_cn = args.in[14], *b_cn = args.in[15],
                *g_om = args.in[16], *g_oc = args.in[17], *w_out = args.in[18], *ln_ffn = args.in[19], *w_gate = args.in[20], *w_up = args.in[21], *w_down = args.in[22], *g_final = args.in[23];
    bf16 *W1t = (bf16*)(ws + WS_W1), *Wq_t = (bf16*)(ws + WS_WQ), *Wkv_t = (bf16*)(ws + WS_WKV), *Wo_t = (bf16*)(ws + WS_WO), *Wgu_t = (bf16*)(ws + WS_WGU), *Wd_t = (bf16*)(ws + WS_WD), *WUKn = (bf16*)(ws + WS_WUKN);
    float* ROPE = (float*)(ws + WS_ROPE);
    bf16 *XN = (bf16*)(ws + WS_XN), *MIX = (bf16*)(ws + WS_MIX), *CQ = (bf16*)(ws + WS_CQ), *CKVN = (bf16*)(ws + WS_CKVN), *KPE = (bf16*)(ws + WS_KPE), *U = (bf16*)(ws + WS_U), *Q = (bf16*)(ws + WS_Q),
         *ACT = (bf16*)(ws + WS_ACT), *KN = (bf16*)(ws + WS_KN), *V = (bf16*)(ws + WS_V), *OMLA = (bf16*)(ws + WS_OMLA), *HB = (bf16*)(ws + WS_HB);
    float *PART = (float*)(ws + WS_PART), *ML = (float*)(ws + WS_ML), *SSQ_Q = (float*)(ws + WS_CTL) + CW_SSQ_Q, *SSQ_H = (float*)(ws + WS_CTL) + CW_SSQ_H, *Y = out + O_Y;

    for (int u = tid0; u < (LDS_BYTES - LDSCTL_OFF) / 4; u += NWAVES * 64) ((LAS unsigned*)(ldsp + LDSCTL_OFF))[u] = 0u;
    __syncthreads();
    XcdBarrier bar; bar.bar = (unsigned*)(ctl + CW_BAR); bar.x = 0; bar.st = nullptr;
    if (N_LAUNCHES != NPHASE) bar = xcd_barrier_post((unsigned*)(ctl + CW_BAR), MISC + 8);
#define GRID_BAR() do { if (N_LAUNCHES == NPHASE) { if (tid0 == 0) __hip_atomic_store(ctl + CW_TMO, 0xBADBA0u, RLX_AGENT); } else { xcd_barrier(bar); } } while (0)
    const int lo = args.ph_lo, hi = args.ph_hi;
#define IN(k) (lo <= (k) && (k) < hi)
#define BOTH(k) (IN(k) && IN((k) + 1))
    const int gw = vcu * NWAVES + wave, NGW = G * NWAVES, NGT = G * NWAVES * 64;

    for (int rep_ = 0; rep_ < 1 + ((MK_DUP >> 0) & 1); ++rep_)
    if (IN(0)) {
        PHASE_IDS();
        LAS float* scr = (LAS float*)(ldsp + RING_OFF + wave * 16384);
        constexpr int I_1 = (DM / 64) * (N1 / 32), I_Q = (QL / 64) * (NQ / 32), I_KV = (KVL / 64) * (NKV / 32), I_O = (DM / 64) * (DM / 32), I_GU = (DM / 64) * (NGU / 32), I_D = (DFF / 64) * (DM / 32);
        constexpr int NITEMS = I_1 + I_Q + I_KV + I_O + I_GU + I_D;
        for (int it = gw; it < NITEMS; it += NGW) {
            int r = it;
            if (r < I_1) { p0_transpose_item(SrcW1{w_in}, DM, W1t, scr, r, lane); continue; } r -= I_1;
            if (r < I_Q) { p0_transpose_item(SrcWq{w_uq, g_q}, QL, Wq_t, scr, r, lane); continue; } r -= I_Q;
            if (r < I_KV) { const bool second = (r % (NKV / 32)) * 32 >= 512; p0_transpose_item(SrcWkv{second ? w_uv : w_uk}, KVL, Wkv_t, scr, r, lane); continue; } r -= I_KV;
            if (r < I_O) { const bool second = (r / (DM / 32)) * 64 >= 512; p0_transpose_item(SrcWo{w_out, second ? g_oc : g_om}, DM, Wo_t, scr, r, lane); continue; } r -= I_O;
            if (r < I_GU) { const bool up = (((r % (NGU / 32)) * 32) & 255) >= 128; p0_transpose_item(SrcWgu{up ? w_up : w_gate, ln_ffn}, DM, Wgu_t, scr, r, lane); continue; } r -= I_GU;
            p0_transpose_item(SrcWd{w_down}, DFF, Wd_t, scr, r, lane);
        }
        for (int m = gw; m < T; m += NGW) rms_row(m < TP ? x_p + (size_t)m * DM : x_s + (size_t)(m - TP) * DM, ln_mix, XN + (size_t)m * DM, nullptr, lane);
        for (int i = gtid; i < NPOS * 16; i += NGT) { const int pi = i >> 4, fi = i & 15; const int pos = pi < SEQ ? pi : PAST + (pi - SEQ);
            const double ang = (double)pos * exp2(-(double)fi * 0.8304820237218406);
            ROPE[2 * i] = (float)cos(ang); ROPE[2 * i + 1] = (float)sin(ang); }
        for (int i = gtid; i < KVL * 512 / 4; i += NGT) { const f32x4 v = *(const f32x4*)(w_uk + (size_t)i * 4); *(unsigned long long*)(WUKn + (size_t)i * 4) = (unsigned long long)pk2(v.x, v.y) | ((unsigned long long)pk2(v.z, v.w) << 32); }
        for (int i = gtid; i < SBATCH * (CST - SSEQ) * CC / 4; i += NGT) { const int c4 = i % (CC / 4), r = (i / (CC / 4)) % (CST - SSEQ), b = i / ((CC / 4) * (CST - SSEQ));
            *(f32x4*)(out + O_CVS + ((size_t)b * CST + r) * CC + c4 * 4) = *(const f32x4*)(st_conv + ((size_t)b * CST + SSEQ + r) * CC + c4 * 4); }
        if (BOTH(0)) GRID_BAR();
        if ((MK_DUP >> 20) & 1) { GRID_BAR(); GRID_BAR(); GRID_BAR(); GRID_BAR(); }
    }
    if (IN(1)) {
        pg8::Gemm g{XN, W1t, T, N1, DM}; pg8::StaticOrder S; S.init(T, N1, G, (int)blockIdx.x);
        if ((MK_DUP >> 1) & 1) { pg8::EpiProj Ed{CKVN, CQ, KPE, U, out, (float*)(ws + WS_ML), g_kv, ROPE, (LAS float*)(ldsp + EX_OFF)};
            pg8::gemm_phase<pg8::EpiProj, pg8::StaticOrder, true, true>(ldsp + RING_OFF, g, S, Ed); GRID_BAR(); }
        pg8::EpiProj E{CKVN, CQ, KPE, U, out, SSQ_Q, g_kv, ROPE, (LAS float*)(ldsp + EX_OFF)};
        pg8::gemm_phase<pg8::EpiProj, pg8::StaticOrder, true, true>(ldsp + RING_OFF, g, S, E);
        if (BOTH(1)) GRID_BAR();
    }
    for (int rep_ = 0; rep_ < 1 + ((MK_DUP >> 2) & 1); ++rep_)
    if (IN(2)) {
        { pg8::Gemm g{CQ, Wq_t, T, NQ, QL}; pg8::StaticOrder S; S.init(T, NQ, G, (int)blockIdx.x);
          pg8::EpiQ E{Q, SSQ_Q, ROPE};
          pg8::gemm_phase<pg8::EpiQ, pg8::StaticOrder, true, true>(ldsp + RING_OFF, g, S, E); }
        { pg8::Gemm g{CKVN, Wkv_t, TP, NKV, KVL}; pg8::StaticOrder S; S.init(TP, NKV, G, (int)blockIdx.x);
          pg8::EpiBf16 E{KN, 512, 512, (size_t)(WS_V - WS_KN) / 2};
          pg8::gemm_phase<pg8::EpiBf16, pg8::StaticOrder, true, true>(ldsp + RING_OFF, g, S, E); }
        if (BOTH(2)) GRID_BAR();
    }
    for (int rep_ = 0; rep_ < 1 + ((MK_DUP >> 3) & 1); ++rep_)
    if (IN(3)) {
        PHASE_IDS();
        for (int p = vcu; p < 256; p += G) { const int bh = p >> 2, s = p & 3;
            att::prompt_unit(bh >> 3, bh & 7, 7 - s, Q, KN, KPE, V, OMLA, (char*)lds + RING_OFF);
            att::prompt_unit(bh >> 3, bh & 7, s, Q, KN, KPE, V, OMLA, (char*)lds + RING_OFF); }
        for (int p = vcu; p < 256; p += G) att::decode_unit(p >> 4, p & 15, Q, WUKn, cache_kv, cache_kr, CKVN, KPE, PART, ML, (att::lptr)(ldsp + RING_OFF));
        if (BOTH(3)) GRID_BAR();
    }
    for (int rep_ = 0; rep_ < 1 + ((MK_DUP >> 4) & 1); ++rep_)
    if (IN(4)) {
        PHASE_IDS();
        for (int p = vcu; p < 256; p += G) att::combine_item(p >> 4, p & 15, PART, ML, Wkv_t, OMLA, (att::lptr)(ldsp + RING_OFF));
        if (BOTH(4)) GRID_BAR();
    }
    for (int rep_ = 0; rep_ < 1 + ((MK_DUP >> 5) & 1); ++rep_)
    if (IN(5)) {
        PHASE_IDS();
        const att::lptr UH = (att::lptr)(ldsp + RING_OFF + att::M_UH); LAS float* WDW = (LAS float*)(ldsp + RING_OFF + att::M_WDW);
        __syncthreads();
        for (int i = tid; i < CW * CC / 4; i += NWAVES * 64) *(LAS f32x4*)(WDW + 4 * i) = *(const f32x4*)(w_dw + 4 * i);
        float bdw[8], gcn[8], bcn[8];
#pragma unroll
        for (int e = 0; e < 8; ++e) { bdw[e] = b_dw[8 * lane + e]; gcn[e] = g_cn[8 * lane + e]; bcn[e] = b_cn[8 * lane + e]; }
        for (int it = vcu; it < 512 + SBATCH; it += G) {
            __syncthreads();
            if (it < 512) { const int r0 = it * 32, b = r0 >> 11, s0 = r0 & (SEQ - 1);
                v4u tmp[8];
#pragma unroll
                for (int k = 0; k < 8; ++k) { const int i = tid + 512 * k, lr = (i >> 6) < 61 ? (i >> 6) : 61, ch = i & 63, s = s0 - CST + lr;
                    const v4u v = *(const v4u*)(U + ((size_t)b * SEQ + (s >= 0 ? s : 0)) * CC + ch * 8); tmp[k] = (s >= 0) ? v : (v4u){0u, 0u, 0u, 0u}; }
#pragma unroll
                for (int k = 0; k < 8; ++k) { const int i = tid + 512 * k; if (i < 62 * 64) *(LAS v4u*)(UH + (i >> 6) * 1024 + (i & 63) * 16) = tmp[k]; }
                __syncthreads();
                att::mix_rows<4>(UH, WDW, wave * 4, (size_t)r0 + wave * 4, bdw, gcn, bcn, OMLA, MIX, lane);
            } else { const int bs = it - 512;
                f32x4 ta[4], tc[4]; v4u tu[2];
#pragma unroll
                for (int k = 0; k < 4; ++k) { const int i = tid + 512 * k, lr = (i >> 6) < CST - 1 ? (i >> 6) : CST - 1, ch = i & 63; const float* sp = st_conv + ((size_t)bs * CST + lr) * CC + ch * 8;
                    ta[k] = *(const f32x4*)sp; tc[k] = *(const f32x4*)(sp + 4); }
#pragma unroll
                for (int k = 0; k < 2; ++k) { const int i = tid + 512 * k; tu[k] = *(const v4u*)(U + ((size_t)TP + bs * SSEQ + (i >> 6)) * CC + (i & 63) * 8); }
#pragma unroll
                for (int k = 0; k < 4; ++k) { const int i = tid + 512 * k; v4u v; v.x = pk2(ta[k].x, ta[k].y); v.y = pk2(ta[k].z, ta[k].w); v.z = pk2(tc[k].x, tc[k].y); v.w = pk2(tc[k].z, tc[k].w);
                    if (i < CST * 64) *(LAS v4u*)(UH + (i >> 6) * 1024 + (i & 63) * 16) = v; }
#pragma unroll
                for (int k = 0; k < 2; ++k) { const int i = tid + 512 * k; *(LAS v4u*)(UH + (CST + (i >> 6)) * 1024 + (i & 63) * 16) = tu[k]; }
                __syncthreads();
                att::mix_rows<2>(UH, WDW, wave * 2, (size_t)TP + bs * SSEQ + wave * 2, bdw, gcn, bcn, OMLA, MIX, lane);
            }
        }
        if (BOTH(5)) GRID_BAR();
    }
    if (IN(6)) {
        pg8::Gemm g{MIX, Wo_t, T, DM, DM}; pg8::PanelSplitOrder S; S.init(G, (int)blockIdx.x, DM, MT6);
        if ((MK_DUP >> 6) & 1) { pg8::PanelSplitOrder Sd; Sd.init(G, (int)blockIdx.x, DM, MT6, ((MK_DUP >> 15) & 1) == 0); pg8::EpiWo Ed{x_p, HB, (float*)(ws + WS_ML), (float*)(ws + WS_SLAB6), MT6, (MK_DUP >> 12) & 7};
            pg8::gemm_phase<pg8::EpiWo, pg8::PanelSplitOrder, true, true>(ldsp + RING_OFF, g, Sd, Ed); GRID_BAR(); }
        pg8::EpiWo E{x_p, HB, SSQ_H, (float*)(ws + WS_SLAB6), MT6, 0};
        pg8::gemm_phase<pg8::EpiWo, pg8::PanelSplitOrder, true, true>(ldsp + RING_OFF, g, S, E);
        if (BOTH(6)) GRID_BAR();
    }
    if (IN(7)) {
        PHASE_IDS();
        for (int r = gw; r < TS; r += NGW) { const GAS f32x4* xr = (const GAS f32x4*)(x_s + (size_t)r * DM) + lane; f32x4 v[4]; float s = 0.f;
#pragma unroll
            for (int j = 0; j < 4; ++j) v[j] = xr[64 * j];
            for (int sl = 0; sl < DM / 64 / MT6; ++sl) { const GAS f32x4* sr = (const GAS f32x4*)((const float*)(ws + WS_SLAB6) + ((size_t)sl * 256 + r) * DM) + lane;
#pragma unroll
                for (int j = 0; j < 4; ++j) v[j] += sr[64 * j]; }
            GAS unsigned long long* o8 = (GAS unsigned long long*)(HB + ((size_t)TP + r) * DM) + lane;
#pragma unroll
            for (int j = 0; j < 4; ++j) { s += (v[j].x * v[j].x + v[j].y * v[j].y) + (v[j].z * v[j].z + v[j].w * v[j].w); o8[64 * j] = (unsigned long long)pk2(v[j].x, v[j].y) | ((unsigned long long)pk2(v[j].z, v[j].w) << 32); }
            s = att::wave_sum(s); if (lane == 0) SSQ_H[TP + r] = s; }
        if (BOTH(7)) GRID_BAR();
    }
    for (int rep_ = 0; rep_ < 1 + ((MK_DUP >> 8) & 1); ++rep_)
    if (IN(8)) {
        pg8::Gemm g{HB, Wgu_t, T, NGU, DM}; pg8::StaticOrder S; S.init(T, NGU, G, (int)blockIdx.x);
        pg8::EpiGU E{ACT, SSQ_H};
        pg8::gemm_phase<pg8::EpiGU, pg8::StaticOrder, true, true>(ldsp + RING_OFF, g, S, E);
        if (BOTH(8)) GRID_BAR();
    }
    if (IN(9)) {
        pg8::Gemm g{ACT, Wd_t, T, DM, DFF}; pg8::PanelSplitOrder S; S.init(G, (int)blockIdx.x, DFF, MT8);
        if ((MK_DUP >> 9) & 1) { pg8::PanelSplitOrder Sd; Sd.init(G, (int)blockIdx.x, DFF, MT8, ((MK_DUP >> 15) & 1) == 0); pg8::EpiDown Ed{(bf16*)(ws + WS_H2), HB, (float*)(ws + WS_SLAB8), MT8};
            pg8::gemm_phase<pg8::EpiDown, pg8::PanelSplitOrder, true, true>(ldsp + RING_OFF, g, Sd, Ed); GRID_BAR(); }
        pg8::EpiDown E{(bf16*)(ws + WS_H2), HB, (float*)(ws + WS_SLAB8), MT8};
        pg8::gemm_phase<pg8::EpiDown, pg8::PanelSplitOrder, true, true>(ldsp + RING_OFF, g, S, E);
        if (BOTH(9)) GRID_BAR();
    }
    if (IN(10)) {
        PHASE_IDS();
        bf16* H2 = (bf16*)(ws + WS_H2);
        if ((MK_DUP >> 10) & 1) { for (int m = gw; m < T; m += NGW) rms_row(nullptr, g_final, nullptr, (float*)(ws + WS_XN) + (size_t)m * DM, lane, m >= TP ? (const float*)(ws + WS_SLAB8) + (size_t)(m - TP) * DM : nullptr, DFF / 64 / MT8, m >= TP ? HB + (size_t)m * DM : H2 + (size_t)m * DM); GRID_BAR(); }
        for (int m = gw; m < T; m += NGW) rms_row(nullptr, g_final, nullptr, Y + (size_t)m * DM, lane, m >= TP ? (const float*)(ws + WS_SLAB8) + (size_t)(m - TP) * DM : nullptr, DFF / 64 / MT8, m >= TP ? HB + (size_t)m * DM : H2 + (size_t)m * DM);
    }
#undef IN
#undef BOTH
}

extern "C" void kernel_launch(void* const* d_in, const int* in_sizes, int n_in, void* d_out, int out_size, void* d_ws, size_t ws_size, hipStream_t stream) {
    static int grid = 0;
    if (grid == 0) {
        if (n_in != 24 || in_sizes[0] != TP * DM || (size_t)out_size != O_END || ws_size < WS_END) { fprintf(stderr, "kernel_launch: shape mismatch (n_in %d, in0 %d, out %d, ws %zu); nothing launched\n", n_in, n_in > 0 ? in_sizes[0] : -1, out_size, ws_size); grid = -1; return; }
        int dev = 0, cus = 0, per_cu = 0;
        if (hipGetDevice(&dev) != hipSuccess || hipDeviceGetAttribute(&cus, hipDeviceAttributeMultiprocessorCount, dev) != hipSuccess) { fprintf(stderr, "kernel_launch: device query failed\n"); grid = -1; return; }
        if (hipFuncSetAttribute((const void*)mk_fwd, hipFuncAttributeMaxDynamicSharedMemorySize, LDS_BYTES) != hipSuccess) { fprintf(stderr, "kernel_launch: hipFuncSetAttribute failed\n"); grid = -1; return; }
        if (hipOccupancyMaxActiveBlocksPerMultiprocessor(&per_cu, (const void*)mk_fwd, NWAVES * 64, LDS_BYTES) != hipSuccess || per_cu < 1) { fprintf(stderr, "kernel_launch: occupancy query says %d workgroups per CU; nothing launched\n", per_cu); (void)hipGetLastError(); grid = -1; return; }
        grid = cus;
    }
    if (grid < 0) return;
    if (hipMemsetAsync((char*)d_ws + WS_CTL, 0, CTL_ZERO_BYTES, stream) != hipSuccess) { fprintf(stderr, "kernel_launch: hipMemsetAsync failed\n"); return; }
    Args a{};
    for (int i = 0; i < 24; ++i) a.in[i] = (const float*)d_in[i];
    a.out = (float*)d_out; a.ws = (unsigned char*)d_ws;
    for (int li = 0; li < N_LAUNCHES; ++li) {
        a.ph_lo = (N_LAUNCHES == NPHASE) ? li : 0; a.ph_hi = (N_LAUNCHES == NPHASE) ? li + 1 : NPHASE;
        hipLaunchKernelGGL(mk_fwd, dim3(grid), dim3(NWAVES * 64), LDS_BYTES, stream, a);
        const hipError_t le = hipPeekAtLastError();
        if (le != hipSuccess) { fprintf(stderr, "kernel_launch: launch %d failed: %s\n", li, hipGetErrorName(le)); break; }
    }
}
```

```cpp
#include <hip/hip_runtime.h>
#include <hip/hip_bf16.h>
#include <cstdio>
#include <cstdint>
#include <cmath>
#define LAS __attribute__((address_space(3)))
#define GAS __attribute__((address_space(1)))

constexpr int DM = 1024, NBATCH = 8, SEQ = 2048, SBATCH = 16, SSEQ = 16, PAST = 4096;
constexpr int TP = NBATCH * SEQ, TS = SBATCH * SSEQ, T = TP + TS;
constexpr int QL = 384, KVL = 256, RD = 32, CC = 512, INW = 1696, NH = 8, DFF = 2816, CW = 31, CST = 30;
constexpr int N1 = 1792, NQ = 768, NKV = 1024, NGU = 2 * DFF;
constexpr float EPS = 1e-6f;
constexpr float QSCALE = 0.10206207261596575f * 1.4426950408889634f;
constexpr int NPOS = SEQ + SSEQ;
constexpr size_t O_Y = 0, O_KVP = (size_t)T * DM, O_KRP = O_KVP + (size_t)TP * KVL, O_CVP = O_KRP + (size_t)TP * RD,
                 O_KVS = O_CVP + (size_t)NBATCH * CST * CC, O_KRS = O_KVS + (size_t)TS * KVL, O_CVS = O_KRS + (size_t)TS * RD, O_END = O_CVS + (size_t)SBATCH * CST * CC;
__device__ __forceinline__ int posidx(int row) { return row < TP ? (row & (SEQ - 1)) : SEQ + ((row - TP) & (SSEQ - 1)); }

namespace pg8 {
#define PG8_LAS __attribute__((address_space(3)))
typedef unsigned short bf16_t;
typedef short bf16x8 __attribute__((ext_vector_type(8)));
typedef float f32x4 __attribute__((ext_vector_type(4)));
typedef unsigned u32x4 __attribute__((ext_vector_type(4)));
constexpr int BM = 256, BK = 64, HALF = 128, HTB = HALF * BK * 2  , STAGE_BYTES = 8 * HTB, NXCD = 8, WGM = 8;

__host__ __device__ __forceinline__ int lds_byte(int r, int c) { const int st = (r >> 4) * 2 + (c >> 5), rr = r & 15, cc = c & 31, ob = rr * 64 + cc * 2; return st * 1024 + (ob ^ (((ob >> 9) & 1) << 5)); }
__host__ __device__ __forceinline__ void stage_rc(int b, int& R, int& C) { const int st = b / 1024, sb = b % 1024, swz = sb ^ (((sb >> 9) & 1) << 5); R = (st >> 1) * 16 + swz / 64; C = (st & 1) * 32 + (swz % 64) / 2; }
__host__ __device__ __forceinline__ int perm32(int rho) { const int n = rho >> 4, i = rho & 15; return 8 * (i >> 2) + 4 * n + (i & 3); }

struct Unit { int pm, pn, kt0, nt, kind; };
struct Gemm { const bf16_t* A; const bf16_t* Bt; int M, N, K; };

struct StaticOrder {
    int nM, nN, nwg, G, c;
    __host__ __device__ void init(int M, int N, int G_, int c_) { nM = M / BM; nN = N / BM; nwg = nM * nN; G = G_; c = c_; }
    __host__ __device__ bool next(int i, Unit& u) const {
        const long L = (long)i * G + c; if (L >= nwg) return false;
        int wgid = (int)L; { const int q = nwg / NXCD, r = nwg % NXCD, xcd = wgid % NXCD, off = wgid / NXCD; wgid = (xcd < r ? xcd * (q + 1) : r * (q + 1) + (xcd - r) * q) + off; }
        const int nig = WGM * nN, gid = wgid / nig, fm = gid * WGM, gsz = (nM - fm) < WGM ? (nM - fm) : WGM;
        u.pm = fm + ((wgid % nig) % gsz); u.pn = (wgid % nig) / gsz; u.kt0 = 0; u.nt = 0; u.kind = 0; return true;
    }
    __device__ __forceinline__ void a_ready(const Unit&) const {}
    __device__ __forceinline__ void done(const Unit&) const {}
};


__device__ __forceinline__ unsigned cvt_pk_bf16(float lo, float hi) { unsigned r; asm volatile("v_cvt_pk_bf16_f32 %0, %1, %2" : "=v"(r) : "v"(lo), "v"(hi)); return r; }
__device__ __forceinline__ u32x4 pack8(f32x4 a, f32x4 b) { u32x4 w; w.x = cvt_pk_bf16(a[0], a[1]); w.y = cvt_pk_bf16(a[2], a[3]); w.z = cvt_pk_bf16(b[0], b[1]); w.w = cvt_pk_bf16(b[2], b[3]); return w; }
__device__ __forceinline__ float sq4(f32x4 v) { return (v[0] * v[0] + v[1] * v[1]) + (v[2] * v[2] + v[3] * v[3]); }
__device__ __forceinline__ float sigm(float x) { return __builtin_amdgcn_rcpf(1.f + __builtin_amdgcn_exp2f(-1.4426950408889634f * x)); }
__device__ __forceinline__ f32x4 sigm4(f32x4 x) { return (f32x4){sigm(x[0]), sigm(x[1]), sigm(x[2]), sigm(x[3])}; }
__device__ __forceinline__ void rope4(const float* tab, f32x4& x1, f32x4& x2) {
    const f32x4 t0 = *(const f32x4*)tab, t1 = *(const f32x4*)(tab + 4);
    const f32x4 c = {t0[0], t0[2], t1[0], t1[2]}, s = {t0[1], t0[3], t1[1], t1[3]};
    const f32x4 y1 = x1 * c - x2 * s, y2 = x2 * c + x1 * s; x1 = y1; x2 = y2;
}

struct EpiBf16 {
    static constexpr bool PERM = true, AFTER_DRAIN = false, HAS_INIT = false;
    bf16_t* O; int ldc; int split_cols; size_t split_stride;
    __device__ __forceinline__ void operator()(const f32x4 (&acc)[2][2][4][2], const Unit& u, int wr, int wc, int fr, int fq) const {
        const int row0 = u.pm * BM + wr * 64 + fr; int colt = u.pn * BM; bf16_t* base = O;
        if (split_cols) { const int t = colt / split_cols; base += (size_t)t * split_stride; colt -= t * split_cols; }
        const int col0 = colt + wc * 32 + 8 * fq;
#pragma unroll
        for (int ai = 0; ai < 2; ++ai)
#pragma unroll
            for (int m = 0; m < 4; ++m) { bf16_t* rowp = base + (size_t)(row0 + ai * HALF + m * 16) * ldc + col0;
#pragma unroll
                for (int bj = 0; bj < 2; ++bj) *(u32x4*)(rowp + bj * HALF) = pack8(acc[ai][bj][m][0], acc[ai][bj][m][1]); }
    }
};

struct EpiProj {
    static constexpr bool PERM = true, AFTER_DRAIN = false, HAS_INIT = false;
    bf16_t *CKVN, *CQ, *KPE, *U; float* out; float* ssq_q; const float* g_kv; const float* rope; PG8_LAS float* ex;
    __device__ __forceinline__ void operator()(const f32x4 (&acc)[2][2][4][2], const Unit& u, int wr, int wc, int fr, int fq) const {
        const bool smp = (u.pm == TP / BM);
        const int rl0 = wr * 64 + fr;
        if (u.pn == 0) {
#pragma unroll
            for (int ai = 0; ai < 2; ++ai)
#pragma unroll
                for (int m = 0; m < 4; ++m) { float s = 0.f;
#pragma unroll
                    for (int bj = 0; bj < 2; ++bj) s += sq4(acc[ai][bj][m][0]) + sq4(acc[ai][bj][m][1]);
                    s += __shfl_xor(s, 16); s += __shfl_xor(s, 32);
                    if (fq == 0) ex[(ai * HALF + rl0 + m * 16) * 4 + wc] = s; }
            asm volatile("s_waitcnt lgkmcnt(0)" ::: "memory"); __builtin_amdgcn_s_barrier(); asm volatile("" ::: "memory");
            const int c0 = wc * 32 + 8 * fq;
            f32x4 g[2][2];
#pragma unroll
            for (int bj = 0; bj < 2; ++bj)
#pragma unroll
                for (int n = 0; n < 2; ++n) g[bj][n] = *(const f32x4*)(g_kv + c0 + bj * HALF + 4 * n);
            float* okv = smp ? out + O_KVS : out + O_KVP + (size_t)u.pm * BM * KVL;
#pragma unroll
            for (int ai = 0; ai < 2; ++ai)
#pragma unroll
                for (int m = 0; m < 4; ++m) { const int rl = ai * HALF + rl0 + m * 16; const f32x4 e = *(const PG8_LAS f32x4*)(ex + rl * 4);
                    const float r = rsqrtf(((e[0] + e[1]) + (e[2] + e[3])) * (1.0f / KVL) + EPS);
                    float* of = okv + (size_t)rl * KVL + c0; bf16_t* ob = CKVN + ((size_t)u.pm * BM + rl) * KVL + c0;
#pragma unroll
                    for (int bj = 0; bj < 2; ++bj) { const f32x4 v0 = acc[ai][bj][m][0] * r * g[bj][0], v1 = acc[ai][bj][m][1] * r * g[bj][1];
                        *(f32x4*)(of + bj * HALF) = v0; *(f32x4*)(of + bj * HALF + 4) = v1; *(u32x4*)(ob + bj * HALF) = pack8(v0, v1); } }
        } else if (u.pn <= 2) {
            const int nbj = (u.pn == 1) ? 2 : 1;
            const int cq0 = (u.pn - 1) * BM + wc * 32 + 8 * fq;
#pragma unroll
            for (int ai = 0; ai < 2; ++ai)
#pragma unroll
                for (int m = 0; m < 4; ++m) { const size_t row = (size_t)u.pm * BM + ai * HALF + rl0 + m * 16; float s = 0.f;
#pragma unroll
                    for (int bj = 0; bj < 2; ++bj) if (bj < nbj) { const f32x4 v0 = acc[ai][bj][m][0], v1 = acc[ai][bj][m][1]; s += sq4(v0) + sq4(v1);
                        *(u32x4*)(CQ + row * QL + cq0 + bj * HALF) = pack8(v0, v1); }
                    s += __shfl_xor(s, 16); s += __shfl_xor(s, 32);
                    if (fq == 0) atomicAdd(ssq_q + row, s);
                    if (u.pn == 2 && wc == 0) { f32x4 x1 = acc[ai][1][m][0], x2 = acc[ai][1][m][1];
                        rope4(rope + ((size_t)posidx((int)row) * 16 + 4 * fq) * 2, x1, x2);
                        float* okr = smp ? out + O_KRS + (row - TP) * RD : out + O_KRP + row * RD;
                        *(f32x4*)(okr + 4 * fq) = x1; *(f32x4*)(okr + 16 + 4 * fq) = x2; *(u32x4*)(KPE + row * RD + 8 * fq) = pack8(x1, x2); } }
        } else {
            const int cu = (u.pn - 3) * HALF + wc * 32 + 8 * fq;
            const bool cvp = !smp && ((u.pm & 7) == 7);
#pragma unroll
            for (int ai = 0; ai < 2; ++ai)
#pragma unroll
                for (int m = 0; m < 4; ++m) { const int rl = ai * HALF + rl0 + m * 16; const size_t row = (size_t)u.pm * BM + rl;
                    const f32x4 u0 = acc[ai][0][m][0] * sigm4(acc[ai][1][m][0]), u1 = acc[ai][0][m][1] * sigm4(acc[ai][1][m][1]);
                    *(u32x4*)(U + row * CC + cu) = pack8(u0, u1);
                    if (smp) { const int r = rl, b = r >> 4, s = r & 15; float* o = out + O_CVS + ((size_t)b * CST + (CST - SSEQ) + s) * CC + cu; *(f32x4*)o = u0; *(f32x4*)(o + 4) = u1; }
                    else if (cvp && rl >= BM - CST) { float* o = out + O_CVP + ((size_t)(u.pm >> 3) * CST + (rl - (BM - CST))) * CC + cu; *(f32x4*)o = u0; *(f32x4*)(o + 4) = u1; } }
        }
    }
};

struct EpiQ {
    static constexpr bool PERM = true, AFTER_DRAIN = false, HAS_INIT = false;
    bf16_t* Q; const float* ssq_q; const float* rope;
    __device__ __forceinline__ void operator()(const f32x4 (&acc)[2][2][4][2], const Unit& u, int wr, int wc, int fr, int fq) const {
        float rr[2][4];
#pragma unroll
        for (int ai = 0; ai < 2; ++ai)
#pragma unroll
            for (int m = 0; m < 4; ++m) rr[ai][m] = ssq_q[(size_t)u.pm * BM + ai * HALF + wr * 64 + m * 16 + fr];
#pragma unroll
        for (int ai = 0; ai < 2; ++ai)
#pragma unroll
            for (int m = 0; m < 4; ++m) { const size_t row = (size_t)u.pm * BM + ai * HALF + wr * 64 + m * 16 + fr;
                const float rq = rsqrtf(rr[ai][m] * (1.0f / QL) + EPS) * QSCALE; const float* tab = rope + (size_t)posidx((int)row) * 32;
#pragma unroll
                for (int bj = 0; bj < 2; ++bj) { const int c0 = u.pn * BM + bj * HALF + wc * 32 + 8 * fq; const int gi = (c0 >> 3) % 12;
                    f32x4 v0 = acc[ai][bj][m][0] * rq, v1 = acc[ai][bj][m][1] * rq;
                    const int g = gi >= 8 ? gi - 8 : 0; f32x4 y1 = v0, y2 = v1; rope4(tab + g * 8, y1, y2);
                    if (gi >= 8) { v0 = y1; v1 = y2; }
                    *(u32x4*)(Q + row * NQ + c0) = pack8(v0, v1); }
                asm volatile("" ::: "memory"); }
    }
};

struct PanelSplitOrder {
    StaticOrder so; int nmini, mt;
    __device__ __forceinline__ void init(int G_, int c_, int K, int mt_, bool minis = true) { so.init(TP, DM, G_, c_); mt = mt_; nmini = minis ? 4 * (K / BK / mt_) : 0; }
    __device__ __forceinline__ bool next(int i, Unit& u) const {
        const long L = (long)i * so.G + so.c;
        if (L < so.nwg) return so.next(i, u);
        const int m = (int)(L - so.nwg); if (m >= nmini) return false;
        u.pm = TP / BM; u.pn = m & 3; u.kt0 = (m >> 2) * mt; u.nt = mt; u.kind = 1; return true;
    }
    __device__ __forceinline__ void a_ready(const Unit&) const {}
    __device__ __forceinline__ void done(const Unit&) const {}
};

struct EpiWo {
    static constexpr bool PERM = true, AFTER_DRAIN = false, HAS_INIT = true;
    const float* xp; bf16_t* HB; float* ssq_h; float* SLAB; int mt; int probe;
    __device__ __forceinline__ void init(f32x4 (&acc)[2][2][4][2], const Unit& u, int wr, int wc, int fr, int fq) const {
        const int cb = u.pn * BM + wc * 32 + 8 * fq;
        if (u.kind == 0) {
#pragma unroll
            for (int ai = 0; ai < 2; ++ai)
#pragma unroll
                for (int m = 0; m < 4; ++m) { const float* xr = xp + ((size_t)u.pm * BM + ai * HALF + wr * 64 + m * 16 + fr) * DM + cb;
#pragma unroll
                    for (int bj = 0; bj < 2; ++bj)
#pragma unroll
                        for (int n = 0; n < 2; ++n) acc[ai][bj][m][n] = *(const f32x4*)(xr + bj * HALF + 4 * n); }
        } else {
#pragma unroll
            for (int ai = 0; ai < 2; ++ai)
#pragma unroll
                for (int m = 0; m < 4; ++m)
#pragma unroll
                    for (int bj = 0; bj < 2; ++bj)
#pragma unroll
                        for (int n = 0; n < 2; ++n) acc[ai][bj][m][n] = (f32x4){0.f, 0.f, 0.f, 0.f};
        }
    }
    __device__ __forceinline__ void operator()(const f32x4 (&acc)[2][2][4][2], const Unit& u, int wr, int wc, int fr, int fq) const {
        const int cb = u.pn * BM + wc * 32 + 8 * fq;
        if (probe == 2) {
#pragma unroll
            for (int ai = 0; ai < 2; ++ai)
#pragma unroll
                for (int bj = 0; bj < 2; ++bj)
#pragma unroll
                    for (int m = 0; m < 4; ++m) asm volatile("" :: "v"(acc[ai][bj][m][0]), "v"(acc[ai][bj][m][1]));
            return; }
        if (u.kind == 0) {
#pragma unroll
            for (int ai = 0; ai < 2; ++ai)
#pragma unroll
                for (int m = 0; m < 4; ++m) { const size_t row = (size_t)u.pm * BM + ai * HALF + wr * 64 + m * 16 + fr; float s = 0.f;
#pragma unroll
                    for (int bj = 0; bj < 2; ++bj) { *(u32x4*)(HB + row * DM + cb + bj * HALF) = pack8(acc[ai][bj][m][0], acc[ai][bj][m][1]); s += sq4(acc[ai][bj][m][0]) + sq4(acc[ai][bj][m][1]); }
                    s += __shfl_xor(s, 16); s += __shfl_xor(s, 32);
                    if (fq == 0) atomicAdd(ssq_h + row, s); }
        } else { const int sl = u.kt0 / mt;
#pragma unroll
            for (int ai = 0; ai < 2; ++ai)
#pragma unroll
                for (int m = 0; m < 4; ++m) { const int rl = ai * HALF + wr * 64 + m * 16 + fr;
#pragma unroll
                    for (int bj = 0; bj < 2; ++bj) { float* sp = SLAB + ((size_t)sl * BM + rl) * DM + cb + bj * HALF; *(f32x4*)sp = acc[ai][bj][m][0]; *(f32x4*)(sp + 4) = acc[ai][bj][m][1]; } }
        }
    }
};

struct EpiGU {
    static constexpr bool PERM = true, AFTER_DRAIN = false, HAS_INIT = false;
    bf16_t* ACT; const float* ssq_h; int probe;
    __device__ __forceinline__ void operator()(const f32x4 (&acc)[2][2][4][2], const Unit& u, int wr, int wc, int fr, int fq) const {
        if (probe == 2) {
#pragma unroll
            for (int ai = 0; ai < 2; ++ai)
#pragma unroll
                for (int bj = 0; bj < 2; ++bj)
#pragma unroll
                    for (int m = 0; m < 4; ++m) asm volatile("" :: "v"(acc[ai][bj][m][0]), "v"(acc[ai][bj][m][1]));
            return; }
        const int c0 = u.pn * HALF + wc * 32 + 8 * fq;
        float rr[2][4];
#pragma unroll
        for (int ai = 0; ai < 2; ++ai)
#pragma unroll
            for (int m = 0; m < 4; ++m) rr[ai][m] = ssq_h[(size_t)u.pm * BM + ai * HALF + wr * 64 + m * 16 + fr];
#pragma unroll
        for (int ai = 0; ai < 2; ++ai)
#pragma unroll
            for (int m = 0; m < 4; ++m) { const size_t row = (size_t)u.pm * BM + ai * HALF + wr * 64 + m * 16 + fr;
                const float r = rsqrtf(rr[ai][m] * (1.0f / DM) + EPS);
                const f32x4 g0 = acc[ai][0][m][0] * r, g1 = acc[ai][0][m][1] * r, u0 = acc[ai][1][m][0] * r, u1 = acc[ai][1][m][1] * r;
                const u32x4 w = pack8(g0 * sigm4(g0) * u0, g1 * sigm4(g1) * u1);
                if (probe != 3) *(u32x4*)(ACT + row * DFF + c0) = w; else asm volatile("" :: "v"(w)); }
    }
};

struct EpiDown {
    static constexpr bool PERM = true, AFTER_DRAIN = false, HAS_INIT = true;
    bf16_t* H2; const bf16_t* HB; float* SLAB; int mt;
    __device__ __forceinline__ void init(f32x4 (&acc)[2][2][4][2], const Unit& u, int wr, int wc, int fr, int fq) const {
        const int cb = u.pn * BM + wc * 32 + 8 * fq;
        if (u.kind == 0) {
#pragma unroll
            for (int ai = 0; ai < 2; ++ai)
#pragma unroll
                for (int m = 0; m < 4; ++m) { const bf16_t* p = HB + ((size_t)u.pm * BM + ai * HALF + wr * 64 + m * 16 + fr) * DM + cb;
#pragma unroll
                    for (int bj = 0; bj < 2; ++bj) { const u32x4 h = *(const u32x4*)(p + bj * HALF);
                        acc[ai][bj][m][0] = (f32x4){__uint_as_float(h.x << 16), __uint_as_float(h.x & 0xffff0000u), __uint_as_float(h.y << 16), __uint_as_float(h.y & 0xffff0000u)};
                        acc[ai][bj][m][1] = (f32x4){__uint_as_float(h.z << 16), __uint_as_float(h.z & 0xffff0000u), __uint_as_float(h.w << 16), __uint_as_float(h.w & 0xffff0000u)}; } }
        } else {
#pragma unroll
            for (int ai = 0; ai < 2; ++ai)
#pragma unroll
                for (int m = 0; m < 4; ++m)
#pragma unroll
                    for (int bj = 0; bj < 2; ++bj)
#pragma unroll
                        for (int n = 0; n < 2; ++n) acc[ai][bj][m][n] = (f32x4){0.f, 0.f, 0.f, 0.f};
        }
    }
    __device__ __forceinline__ void operator()(const f32x4 (&acc)[2][2][4][2], const Unit& u, int wr, int wc, int fr, int fq) const {
        const int sl = u.kt0 / mt; const int cb = u.pn * BM + wc * 32 + 8 * fq;
        if (u.kind == 0) {
#pragma unroll
            for (int ai = 0; ai < 2; ++ai)
#pragma unroll
                for (int m = 0; m < 4; ++m) { bf16_t* p = H2 + ((size_t)u.pm * BM + ai * HALF + wr * 64 + m * 16 + fr) * DM + cb;
#pragma unroll
                    for (int bj = 0; bj < 2; ++bj) *(u32x4*)(p + bj * HALF) = pack8(acc[ai][bj][m][0], acc[ai][bj][m][1]); }
        } else {
#pragma unroll
            for (int ai = 0; ai < 2; ++ai)
#pragma unroll
                for (int m = 0; m < 4; ++m) { const int rl = ai * HALF + wr * 64 + m * 16 + fr;
#pragma unroll
                    for (int bj = 0; bj < 2; ++bj) { float* p = SLAB + ((size_t)sl * BM + rl) * DM + cb + bj * HALF; *(f32x4*)p = acc[ai][bj][m][0]; *(f32x4*)(p + 4) = acc[ai][bj][m][1]; } }
        }
    }
};

template <class Epi, class Sched, bool ALIGN_EPI = false, bool SP2 = false>
__device__ __forceinline__ void gemm_phase(PG8_LAS unsigned char* lds, const Gemm g, const Sched& S, const Epi& E) {
    int tid_ = threadIdx.x; asm volatile("" : "+v"(tid_));
    const int tid = tid_, wid = __builtin_amdgcn_readfirstlane(tid >> 6), lane = tid & 63, wr = wid >> 2, wc = wid & 3, fr = lane & 15, fq = lane >> 4;
    int K_ = g.K; asm volatile("" : "+s"(K_));
    const int K = K_, nt = K / BK;
    unsigned voffA[2], voffB[2];
#pragma unroll
    for (int i = 0; i < 2; ++i) { int R, C; stage_rc(tid * 16 + i * 8192, R, C); const int Rb = Epi::PERM ? ((R & ~31) + perm32(R & 31)) : R;
        voffA[i] = (unsigned)(R * K + C) * 2u; voffB[i] = (unsigned)(Rb * K + C) * 2u; }
    const size_t kstep = (size_t)(BK * 2);
    const size_t hstep = (size_t)HALF * K * 2;
    const size_t tstep = 2 * hstep;
    const unsigned ldsw = (unsigned)wid * 1024u;
    const int aoff = lds_byte(wr * 64 + fr, fq * 8), boff = lds_byte(wc * 32 + fr, fq * 8);
#define PG8_SA(b, h) (((b) * 2 + (h)) * HTB)
#define PG8_SB(b, h) ((4 + (b) * 2 + (h)) * HTB)
#define PG8_STAGE(bufoff, gbase, voff) do { _Pragma("unroll") for (int _i = 0; _i < 2; ++_i) \
        __builtin_amdgcn_global_load_lds((const unsigned*)((const char*)(gbase) + (voff)[_i]), (PG8_LAS unsigned*)(lds + (bufoff) + ldsw + _i * 8192), 16, 0, 0); } while (0)
#define PG8_LDA(dst, b, h) do { _Pragma("unroll") for (int m = 0; m < 4; ++m) _Pragma("unroll") for (int k = 0; k < 2; ++k) dst[m][k] = *(const PG8_LAS bf16x8*)(lds + PG8_SA(b, h) + aoff + m * 2048 + k * 1024); } while (0)
#define PG8_LDB(dst, b, h) do { _Pragma("unroll") for (int n = 0; n < 2; ++n) _Pragma("unroll") for (int k = 0; k < 2; ++k) dst[n][k] = *(const PG8_LAS bf16x8*)(lds + PG8_SB(b, h) + boff + n * 2048 + k * 1024); } while (0)
#define PG8_MMA(ai, bj, At, Bt) do { __builtin_amdgcn_s_setprio(1); _Pragma("unroll") for (int m = 0; m < 4; ++m) _Pragma("unroll") for (int n = 0; n < 2; ++n) _Pragma("unroll") for (int k = 0; k < 2; ++k) \
        acc[ai][bj][m][n] = __builtin_amdgcn_mfma_f32_16x16x32_bf16(Bt[n][k], At[m][k], acc[ai][bj][m][n], 0, 0, 0); __builtin_amdgcn_s_setprio(0); } while (0)
#define PG8_WAIT_V(n) asm volatile("s_waitcnt vmcnt(" #n ")" ::: "memory")
#define PG8_WAIT_L(n) asm volatile("s_waitcnt lgkmcnt(" #n ")" ::: "memory")
#define PG8_BAR __builtin_amdgcn_s_barrier()
#define PG8_SCHED __builtin_amdgcn_sched_barrier(0)
    Unit cur, nxt; int ui = 0;
    if (!S.next(0, cur)) return;
    f32x4 acc[2][2][4][2];
#define PG8_ACC_INIT(u) do { if constexpr (Epi::HAS_INIT) { int t3 = tid; asm volatile("" : "+v"(t3)); E.init(acc, (u), wr, wc, t3 & 15, (t3 >> 4) & 3); } else { \
        _Pragma("unroll") for (int a = 0; a < 2; ++a) _Pragma("unroll") for (int b = 0; b < 2; ++b) _Pragma("unroll") for (int m = 0; m < 4; ++m) _Pragma("unroll") for (int n = 0; n < 2; ++n) acc[a][b][m][n] = (f32x4){0.f, 0.f, 0.f, 0.f}; } } while (0)
    PG8_ACC_INIT(cur);
    bf16x8 At[4][2], B0[2][2], B1[2][2];
#define PG8_UA(u) ((const char*)g.A + (size_t)(u).pm * tstep + (size_t)(u).kt0 * kstep)
#define PG8_UB(u) ((const char*)g.Bt + (size_t)(u).pn * tstep + (size_t)(u).kt0 * kstep)
    const char* cA = PG8_UA(cur); const char* cB = PG8_UB(cur);
    S.a_ready(cur);
    if constexpr (SP2) {
        PG8_STAGE(PG8_SB(0, 0), cB, voffB); PG8_STAGE(PG8_SB(0, 1), cB + hstep, voffB); PG8_STAGE(PG8_SA(0, 0), cA, voffA); PG8_STAGE(PG8_SA(0, 1), cA + hstep, voffA);
        if (wr == 1) PG8_BAR;
        PG8_WAIT_V(2); PG8_BAR;
        PG8_STAGE(PG8_SB(1, 0), cB + kstep, voffB); PG8_STAGE(PG8_SA(1, 0), cA + kstep, voffA); PG8_STAGE(PG8_SB(1, 1), cB + hstep + kstep, voffB);
        PG8_WAIT_V(6); PG8_BAR;
    } else {
        PG8_STAGE(PG8_SB(0, 0), cB, voffB); PG8_STAGE(PG8_SA(0, 0), cA, voffA); PG8_STAGE(PG8_SB(0, 1), cB + hstep, voffB); PG8_STAGE(PG8_SA(0, 1), cA + hstep, voffA);
        if (wr == 1) PG8_BAR;
        PG8_WAIT_V(4); PG8_BAR;
        PG8_STAGE(PG8_SB(1, 0), cB + kstep, voffB); PG8_STAGE(PG8_SA(1, 0), cA + kstep, voffA); PG8_STAGE(PG8_SB(1, 1), cB + hstep + kstep, voffB);
        PG8_WAIT_V(6); PG8_BAR;
    }
    for (;;) {
        const bool has_next = S.next(ui + 1, nxt);
        const char* nA = has_next ? PG8_UA(nxt) : cA; const char* nB = has_next ? PG8_UB(nxt) : cB;
        const int unt = cur.nt ? cur.nt : nt;
        for (int t = 0; t < unt; t += 2) {
            const bool last = (t == unt - 2);
            const char* a1 = cA + (size_t)(t + 1) * kstep;
            const char* a2 = last ? nA : cA + (size_t)(t + 2) * kstep; const char* b2 = last ? nB : cB + (size_t)(t + 2) * kstep;
            const char* a3 = a2 + kstep; const char* b3 = b2 + kstep;
            if (last && has_next) S.a_ready(nxt);
            if constexpr (SP2) {
            PG8_LDB(B0, 0, 0); PG8_LDB(B1, 0, 1); PG8_SCHED; PG8_LDA(At, 0, 0); PG8_STAGE(PG8_SA(1, 1), a1 + hstep, voffA);
            PG8_WAIT_V(8); PG8_WAIT_L(0); PG8_BAR; PG8_MMA(0, 0, At, B0); PG8_MMA(0, 1, At, B1); PG8_BAR; PG8_SCHED;
            PG8_LDA(At, 0, 1); PG8_STAGE(PG8_SB(0, 0), b2, voffB); PG8_STAGE(PG8_SB(0, 1), b2 + hstep, voffB); PG8_STAGE(PG8_SA(0, 0), a2, voffA);
            PG8_WAIT_V(8); PG8_WAIT_L(0); PG8_BAR; PG8_MMA(1, 0, At, B0); PG8_MMA(1, 1, At, B1); PG8_BAR; PG8_SCHED;
            PG8_LDB(B0, 1, 0); PG8_LDB(B1, 1, 1); PG8_SCHED; PG8_LDA(At, 1, 0); PG8_STAGE(PG8_SA(0, 1), a2 + hstep, voffA);
            PG8_WAIT_V(8); PG8_WAIT_L(0); PG8_BAR; PG8_MMA(0, 0, At, B0); PG8_MMA(0, 1, At, B1); PG8_BAR; PG8_SCHED;
            PG8_LDA(At, 1, 1); PG8_STAGE(PG8_SB(1, 0), b3, voffB); PG8_STAGE(PG8_SB(1, 1), b3 + hstep, voffB); PG8_STAGE(PG8_SA(1, 0), a3, voffA);
            PG8_WAIT_V(8); PG8_WAIT_L(0); PG8_BAR; PG8_MMA(1, 0, At, B0); PG8_MMA(1, 1, At, B1); PG8_BAR; PG8_SCHED;
            } else {
            PG8_LDB(B0, 0, 0); PG8_SCHED; PG8_LDA(At, 0, 0); PG8_STAGE(PG8_SA(1, 1), a1 + hstep, voffA);
            PG8_WAIT_L(8); PG8_BAR; PG8_WAIT_L(0); PG8_MMA(0, 0, At, B0); PG8_BAR; PG8_SCHED;
            PG8_LDB(B1, 0, 1); PG8_STAGE(PG8_SB(0, 0), b2, voffB);
            PG8_BAR; PG8_WAIT_L(0); PG8_MMA(0, 1, At, B1); PG8_BAR;
            PG8_LDA(At, 0, 1); PG8_STAGE(PG8_SA(0, 0), a2, voffA);
            PG8_BAR; PG8_WAIT_L(0); PG8_MMA(1, 0, At, B0); PG8_BAR; PG8_SCHED;
            PG8_STAGE(PG8_SB(0, 1), b2 + hstep, voffB);
            PG8_WAIT_V(6); PG8_BAR; PG8_MMA(1, 1, At, B1); PG8_BAR;
            PG8_LDB(B0, 1, 0); PG8_SCHED; PG8_LDA(At, 1, 0); PG8_STAGE(PG8_SA(0, 1), a2 + hstep, voffA);
            PG8_WAIT_L(8); PG8_BAR; PG8_WAIT_L(0); PG8_MMA(0, 0, At, B0); PG8_BAR; PG8_SCHED;
            PG8_LDB(B1, 1, 1); PG8_STAGE(PG8_SB(1, 0), b3, voffB);
            PG8_BAR; PG8_WAIT_L(0); PG8_MMA(0, 1, At, B1); PG8_BAR;
            PG8_LDA(At, 1, 1); PG8_STAGE(PG8_SA(1, 0), a3, voffA);
            PG8_BAR; PG8_WAIT_L(0); PG8_MMA(1, 0, At, B0); PG8_BAR; PG8_SCHED;
            PG8_STAGE(PG8_SB(1, 1), b3 + hstep, voffB);
            PG8_WAIT_V(6); PG8_BAR; PG8_MMA(1, 1, At, B1); PG8_BAR;
            }
        }
        if constexpr (ALIGN_EPI) { if (wr == 0) PG8_BAR; }
        if constexpr (!Epi::AFTER_DRAIN) { int t2 = tid; asm volatile("" : "+v"(t2)); const int fr2 = t2 & 15, fq2 = (t2 >> 4) & 3;
            E(acc, cur, wr, wc, fr2, fq2); S.done(cur); }
        if (!has_next) break;
        PG8_ACC_INIT(nxt);
        cur = nxt; cA = nA; cB = nB; ++ui;
        if constexpr (ALIGN_EPI) { if (wr == 1) PG8_BAR; }
    }
    PG8_WAIT_V(0);
    if constexpr (!ALIGN_EPI) { if (wr == 0) PG8_BAR; }
    PG8_BAR;
    if constexpr (Epi::AFTER_DRAIN) { E.fused(acc, cur, wr, wc, fr, fq, lds, wid, lane); S.done(cur); }
#undef PG8_ACC_INIT
#undef PG8_UA
#undef PG8_UB
#undef PG8_SA
#undef PG8_SB
#undef PG8_STAGE
#undef PG8_LDA
#undef PG8_LDB
#undef PG8_MMA
#undef PG8_WAIT_V
#undef PG8_WAIT_L
#undef PG8_BAR
#undef PG8_SCHED
}
}
namespace att {
using bf16x8 = __attribute__((ext_vector_type(8))) short;
using s16x4 = __attribute__((ext_vector_type(4))) short;
using f32x16 = __attribute__((ext_vector_type(16))) float;
using f32x4 = __attribute__((ext_vector_type(4))) float;
using u32x4 = __attribute__((ext_vector_type(4))) unsigned;
using u32x2 = __attribute__((ext_vector_type(2))) unsigned;
typedef unsigned short bf16;
typedef LAS char* lptr;
typedef short v4i16_t __attribute__((ext_vector_type(4)));
#define SBAR() __builtin_amdgcn_sched_barrier(0)
__device__ __forceinline__ int crow(int r, int hi) { return (r & 3) + 8 * (r >> 2) + 4 * hi; }
__device__ __forceinline__ void glds16(const void* gsrc, unsigned lds_dst) { unsigned keep;
    asm volatile("s_mov_b32 %0, m0\n\ts_mov_b32 m0, %2\n\ts_nop 0\n\tglobal_load_lds_dwordx4 %1, off\n\ts_mov_b32 m0, %0" : "=&s"(keep) : "v"(gsrc), "s"(lds_dst) : "memory"); }
__device__ __forceinline__ float max3f(float a, float b, float c) { float r; asm("v_max3_f32 %0, %1, %2, %3" : "=v"(r) : "v"(a), "v"(b), "v"(c)); return r; }
__device__ __forceinline__ float max2f(float a, float b) { float r; asm("v_max_f32_e32 %0, %1, %2" : "=v"(r) : "v"(a), "v"(b)); return r; }
typedef float f32x2_t __attribute__((ext_vector_type(2))); typedef __bf16 bf16x2_t __attribute__((ext_vector_type(2)));
__device__ __forceinline__ unsigned cvtpk_s(float lo, float hi) { f32x2_t v = {lo, hi}; bf16x2_t b = __builtin_convertvector(v, bf16x2_t); return __builtin_bit_cast(unsigned, b); }
__device__ __forceinline__ unsigned short f2bf(float f) { unsigned u = __builtin_bit_cast(unsigned, f); return (unsigned short)((u + 0x7fffu + ((u >> 16) & 1u)) >> 16); }
__device__ __forceinline__ float wave_sum(float v) {
    v += __builtin_bit_cast(float, __builtin_amdgcn_update_dpp(0, __builtin_bit_cast(int, v), 0xB1, 0xF, 0xF, true));
    v += __builtin_bit_cast(float, __builtin_amdgcn_update_dpp(0, __builtin_bit_cast(int, v), 0x4E, 0xF, 0xF, true));
    v += __builtin_bit_cast(float, __builtin_amdgcn_update_dpp(0, __builtin_bit_cast(int, v), 0x141, 0xF, 0xF, true));
    v += __builtin_bit_cast(float, __builtin_amdgcn_update_dpp(0, __builtin_bit_cast(int, v), 0x140, 0xF, 0xF, true));
    { auto r = __builtin_amdgcn_permlane16_swap(__float_as_uint(v), __float_as_uint(v), false, false); v = __uint_as_float(r[0]) + __uint_as_float(r[1]); }
    { auto r = __builtin_amdgcn_permlane32_swap(__float_as_uint(v), __float_as_uint(v), false, false); v = __uint_as_float(r[0]) + __uint_as_float(r[1]); }
    return v;
}
#define WAIT_ALL_BAR() asm volatile("s_waitcnt vmcnt(0) lgkmcnt(0)\n\ts_barrier" ::: "memory")

constexpr int KSLOT = 12288, VSLOT = 8192, NKS = 2, NVS = 3;
constexpr int L_K = 0, L_V = NKS * KSLOT, L_WS = L_V + NVS * VSLOT, L_OST = L_WS + 8 * 256, L_END = L_OST + 8 * 4096;

__device__ __forceinline__ void qkt6(f32x16& p0, f32x16& p1, const char* Kslot, const bf16x8* qr, int r32, int hi) {
    const char* kb = Kslot + hi * 1024 + r32 * 16;
    const f32x16 z = f32x16{};
#pragma unroll
    for (int d0 = 0; d0 < 6; ++d0) {
        const bf16x8 b0 = *reinterpret_cast<const bf16x8*>(kb + d0 * 2048);
        const bf16x8 b1 = *reinterpret_cast<const bf16x8*>(kb + d0 * 2048 + 512);
        if (d0 == 0) { p0 = __builtin_amdgcn_mfma_f32_32x32x16_bf16(b0, qr[0], z, 0, 0, 0); p1 = __builtin_amdgcn_mfma_f32_32x32x16_bf16(b1, qr[0], z, 0, 0, 0); }
        else { p0 = __builtin_amdgcn_mfma_f32_32x32x16_bf16(b0, qr[d0], p0, 0, 0, 0); p1 = __builtin_amdgcn_mfma_f32_32x32x16_bf16(b1, qr[d0], p1, 0, 0, 0); } }
}
__device__ __forceinline__ float rowmax(const f32x16& p0, const f32x16& p1) {
    float a = max3f(p0[0], p0[1], p1[0]), b = max3f(p0[2], p0[3], p1[1]); a = max3f(a, p1[2], p1[3]);
#pragma unroll
    for (int r = 4; r < 16; r += 4) { a = max3f(a, p0[r], p0[r + 1]); b = max3f(b, p0[r + 2], p0[r + 3]); a = max3f(a, p1[r], p1[r + 1]); b = max3f(b, p1[r + 2], p1[r + 3]); }
    const float m = max2f(a, b);
    auto rr = __builtin_amdgcn_permlane32_swap(__float_as_uint(m), __float_as_uint(m), false, false);
    return max2f(__uint_as_float(rr[0]), __uint_as_float(rr[1]));
}
__device__ __forceinline__ void pv(f32x16* o, int vb, bf16x8 pa0, bf16x8 pa1, bf16x8 pa2, bf16x8 pa3) {
#pragma unroll
    for (int d0 = 0; d0 < 2; ++d0) { s16x4 lo[4], hi[4];
#pragma unroll
        for (int ks = 0; ks < 4; ++ks) {
            asm volatile("ds_read_b64_tr_b16 %0,%1 offset:%c2" : "=&v"(lo[ks]) : "v"(vb), "i"(d0 * 4096 + ks * 1024) : "memory");
            asm volatile("ds_read_b64_tr_b16 %0,%1 offset:%c2" : "=&v"(hi[ks]) : "v"(vb), "i"(d0 * 4096 + ks * 1024 + 512) : "memory"); }
        asm volatile("s_waitcnt lgkmcnt(0)" ::: "memory"); SBAR();
#define PK(k) (bf16x8){lo[k][0], lo[k][1], lo[k][2], lo[k][3], hi[k][0], hi[k][1], hi[k][2], hi[k][3]}
        o[d0] = __builtin_amdgcn_mfma_f32_32x32x16_bf16(pa0, PK(0), o[d0], 0, 0, 0);
        o[d0] = __builtin_amdgcn_mfma_f32_32x32x16_bf16(pa1, PK(1), o[d0], 0, 0, 0);
        o[d0] = __builtin_amdgcn_mfma_f32_32x32x16_bf16(pa2, PK(2), o[d0], 0, 0, 0);
        o[d0] = __builtin_amdgcn_mfma_f32_32x32x16_bf16(pa3, PK(3), o[d0], 0, 0, 0);
#undef PK
    }
}

__device__ __forceinline__ void prompt_unit(int b, int h, int qb, const bf16* Q, const bf16* __restrict__ KN, const bf16* __restrict__ KPE, const bf16* __restrict__ V, bf16* O, char* shm) {
    int tid_ = threadIdx.x; asm volatile("" : "+v"(tid_)); const int tid = tid_, lane = tid & 63, r32 = lane & 31, hi = lane >> 5; const int wid = __builtin_amdgcn_readfirstlane(tid >> 6);
    const long rowbase = (long)b * SEQ; const int q0 = qb * 256;
    const bf16* Qw = Q + (rowbase + q0 + wid * 32) * NQ + h * 96;
    const unsigned lds0 = (unsigned)(uintptr_t)shm;
    float* wsf = (float*)(shm + L_WS) + wid * 64;
    const bf16* ksrc = KN + (rowbase + lane) * 512 + h * 64 + wid * 8;
    const bf16* psrc = KPE + (rowbase + lane) * RD + (wid & 3) * 8;
    const bf16* vsrc = V + (rowbase + 16 * (wid & 3) + (lane >> 2)) * 512 + h * 64 + (wid >> 2) * 32 + (lane & 3) * 8;
    const unsigned kdst = lds0 + L_K + wid * 1024, pdst = lds0 + L_K + (8 + (wid & 3)) * 1024, vdst = lds0 + L_V + wid * 1024;
#define DMA_KV(t, ks, vs) do { glds16(ksrc + (long)(t) * 64 * 512, (unsigned)__builtin_amdgcn_readfirstlane(kdst + (ks) * KSLOT)); \
        if (wid < 4) glds16(psrc + (long)(t) * 64 * RD, (unsigned)__builtin_amdgcn_readfirstlane(pdst + (ks) * KSLOT)); \
        glds16(vsrc + (long)(t) * 64 * 512, (unsigned)__builtin_amdgcn_readfirstlane(vdst + (vs) * VSLOT)); } while (0)
    const int vb0 = (int)(lds0 + L_V) + ((lane >> 4) & 1) * 32 + (lane & 3) * 8 + (4 * hi + ((lane & 15) >> 2)) * 64;
    const char* Kbase = shm + L_K;
    const int NT = 4 * qb + 4, nvis = 4 * qb + (wid >> 1) + 1;
    DMA_KV(0, 0, 0);
    bf16x8 qr[6];
#pragma unroll
    for (int d0 = 0; d0 < 6; ++d0) qr[d0] = *reinterpret_cast<const bf16x8*>(&Qw[(long)r32 * NQ + d0 * 16 + hi * 8]);
    float m = -1e30f, l = 0.f; f32x16 o[2]; o[0] = f32x16{}; o[1] = f32x16{};
    f32x16 p0, p1;
    WAIT_ALL_BAR();
#define SM_PV(vs) do { const float rm = rowmax(p0, p1); \
        const float mn = __builtin_fmaxf(m, rm); const float f = __builtin_amdgcn_exp2f(m - mn); m = mn; float sacc = 0.f; \
        _Pragma("unroll") for (int r = 0; r < 16; ++r) { p0[r] = __builtin_amdgcn_exp2f(p0[r] - mn); p1[r] = __builtin_amdgcn_exp2f(p1[r] - mn); sacc += p0[r] + p1[r]; } \
        l = l * f + sacc; \
        if (__any(f != 1.0f)) { if (hi == 0) wsf[r32] = f; asm volatile("s_waitcnt lgkmcnt(0)" ::: "memory"); \
            _Pragma("unroll") for (int r = 0; r < 16; ++r) { const float fr_ = wsf[crow(r, hi)]; o[0][r] *= fr_; o[1][r] *= fr_; } } \
        const u32x4 pw0 = {cvtpk_s(p0[0], p0[1]), cvtpk_s(p0[2], p0[3]), cvtpk_s(p0[4], p0[5]), cvtpk_s(p0[6], p0[7])}; \
        const u32x4 pw1 = {cvtpk_s(p0[8], p0[9]), cvtpk_s(p0[10], p0[11]), cvtpk_s(p0[12], p0[13]), cvtpk_s(p0[14], p0[15])}; \
        const u32x4 pw2 = {cvtpk_s(p1[0], p1[1]), cvtpk_s(p1[2], p1[3]), cvtpk_s(p1[4], p1[5]), cvtpk_s(p1[6], p1[7])}; \
        const u32x4 pw3 = {cvtpk_s(p1[8], p1[9]), cvtpk_s(p1[10], p1[11]), cvtpk_s(p1[12], p1[13]), cvtpk_s(p1[14], p1[15])}; \
        pv(o, vb0 + (vs) * VSLOT, __builtin_bit_cast(bf16x8, pw0), __builtin_bit_cast(bf16x8, pw1), __builtin_bit_cast(bf16x8, pw2), __builtin_bit_cast(bf16x8, pw3)); } while (0)
    int ks = 0, vs = 0, vsp = 0;
    if (wid < 4) {
        for (int t = 0; t < NT; ++t) {
            const int vsn = (vs == NVS - 1) ? 0 : vs + 1;
            if (t + 1 < NT) DMA_KV(t + 1, ks ^ 1, vsn);
            if (t < nvis) { qkt6(p0, p1, Kbase + ks * KSLOT, qr, r32, hi); SM_PV(vs); }
            WAIT_ALL_BAR();
            ks ^= 1; vs = vsn;
        }
    } else {
        for (int t = 0; t < NT; ++t) {
            const int vsn = (vs == NVS - 1) ? 0 : vs + 1;
            if (t + 1 < NT) DMA_KV(t + 1, ks ^ 1, vsn);
            if (t >= 1 && t - 1 < nvis) SM_PV(vsp);
            if (t < nvis) qkt6(p0, p1, Kbase + ks * KSLOT, qr, r32, hi);
            WAIT_ALL_BAR();
            ks ^= 1; vsp = vs; vs = vsn;
        }
        if (NT - 1 < nvis) SM_PV(vsp);
    }
#undef SM_PV
    { auto rr = __builtin_amdgcn_permlane32_swap(__float_as_uint(l), __float_as_uint(l), false, false); l = __uint_as_float(rr[0]) + __uint_as_float(rr[1]); }
    if (hi == 0) wsf[32 + r32] = l;
    asm volatile("s_waitcnt lgkmcnt(0)" ::: "memory");
    float rli[16];
#pragma unroll
    for (int r = 0; r < 16; ++r) rli[r] = __builtin_amdgcn_rcpf(wsf[32 + crow(r, hi)]);
    bf16* Ow = O + (rowbase + q0 + wid * 32) * 512 + h * 64;
    { bf16* stg = (bf16*)(shm + L_OST) + wid * 2048;
#pragma unroll
        for (int r = 0; r < 16; ++r) { const int orow = crow(r, hi);
#pragma unroll
            for (int d0 = 0; d0 < 2; ++d0) stg[orow * 64 + d0 * 32 + r32] = f2bf(o[d0][r] * rli[r]); }
        asm volatile("s_waitcnt lgkmcnt(0)" ::: "memory");
#pragma unroll
        for (int i = 0; i < 4; ++i) { const int row = i * 8 + (lane >> 3), ch = lane & 7; const u32x4 v = *(const u32x4*)(stg + row * 64 + ch * 8); *(u32x4*)(Ow + (long)row * 512 + ch * 8) = v; } }
    asm volatile("s_waitcnt lgkmcnt(0)\n\ts_barrier" ::: "memory");
#undef DMA_KV
}

constexpr int DQS = 592, D_QL = 0, D_KT = 128 * DQS, D_END = D_KT + 64 * DQS;
__device__ __forceinline__ void decode_unit(int b, int sp, const bf16* Q, const bf16* __restrict__ WUKn, const float* __restrict__ cache_kv, const float* __restrict__ cache_kr,
                                            const bf16* __restrict__ CKVN, const bf16* __restrict__ KPE, const bf16* __restrict__ Wkv_t, float* PART, float* ML, lptr shm) {
    int tid_ = threadIdx.x; asm volatile("" : "+v"(tid_)); const int tid = tid_, lane = tid & 63, fr = lane & 15, g = lane >> 4; const int w = __builtin_amdgcn_readfirstlane(tid >> 6);
    const lptr QLp = shm + D_QL, KTp = shm + D_KT;
    const float* kc = cache_kv + ((size_t)b * PAST + (size_t)sp * 256) * KVL; const float* kr = cache_kr + ((size_t)b * PAST + (size_t)sp * 256) * RD;
    f32x4 pre[9];
#define DEC_LOAD(t) do { const float* kc_ = kc + (size_t)(t) * 64 * KVL + tid * 4; _Pragma("unroll") for (int i_ = 0; i_ < 8; ++i_) pre[i_] = *(const f32x4*)(kc_ + i_ * 2048); \
        pre[8] = *(const f32x4*)(kr + (size_t)(t) * 64 * RD + tid * 4); } while (0)
#define DEC_STORE() do { _Pragma("unroll") for (int i_ = 0; i_ < 8; ++i_) { u32x2 w_; w_.x = cvtpk_s(pre[i_][0], pre[i_][1]); w_.y = cvtpk_s(pre[i_][2], pre[i_][3]); \
            *(LAS u32x2*)(KTp + ((tid >> 6) + 8 * i_) * DQS + (tid & 63) * 8) = w_; } \
        { const int a_ = tid & 7; u32x2 w_; w_.x = cvtpk_s(pre[8][0], pre[8][1]); w_.y = cvtpk_s(pre[8][2], pre[8][3]); \
            *(LAS u32x2*)(KTp + (tid >> 3) * DQS + 512 + 16 * (a_ & 3) + 8 * (a_ >> 2)) = w_; } } while (0)
    DEC_LOAD(0);
    __syncthreads();
    const bf16* qrow = Q + ((size_t)TP + b * SSEQ + fr) * NQ + w * 96;
    *(LAS u32x4*)(QLp + (16 * w + fr) * DQS + 512 + 16 * g) = *(const u32x4*)(qrow + 64 + 8 * g);
    { const bf16x8 qf0 = *(const bf16x8*)(qrow + 8 * g), qf1 = *(const bf16x8*)(qrow + 32 + 8 * g);
#pragma unroll 4
        for (int cb = 0; cb < 16; ++cb) { const bf16* wr_ = WUKn + (size_t)(16 * cb + fr) * 512 + w * 64 + 8 * g;
            f32x4 a = {0.f, 0.f, 0.f, 0.f};
            a = __builtin_amdgcn_mfma_f32_16x16x32_bf16(*(const bf16x8*)wr_, qf0, a, 0, 0, 0);
            a = __builtin_amdgcn_mfma_f32_16x16x32_bf16(*(const bf16x8*)(wr_ + 32), qf1, a, 0, 0, 0);
            u32x2 w_; w_.x = cvtpk_s(a[0], a[1]); w_.y = cvtpk_s(a[2], a[3]);
            *(LAS u32x2*)(QLp + (16 * w + fr) * DQS + (16 * cb + 4 * g) * 2) = w_; } }
    DEC_STORE();
    __syncthreads();
    const int NT = 4 + (sp == 15 ? 1 : 0);
    float m = -1e30f, l = 0.f; f32x4 o[16];
#pragma unroll
    for (int cb = 0; cb < 16; ++cb) o[cb] = (f32x4){0.f, 0.f, 0.f, 0.f};
    for (int t = 0; t < NT; ++t) {
        if (t + 1 < 4) DEC_LOAD(t + 1);
        f32x4 s[4];
#pragma unroll
        for (int kb = 0; kb < 4; ++kb) s[kb] = (f32x4){0.f, 0.f, 0.f, 0.f};
#pragma unroll
        for (int ds = 0; ds < 9; ++ds) { const bf16x8 qf = *(const LAS bf16x8*)(QLp + (16 * w + fr) * DQS + (32 * ds + 8 * g) * 2);
#pragma unroll
            for (int kb = 0; kb < 4; ++kb) { const bf16x8 kf = *(const LAS bf16x8*)(KTp + (16 * kb + fr) * DQS + (32 * ds + 8 * g) * 2);
                s[kb] = __builtin_amdgcn_mfma_f32_16x16x32_bf16(kf, qf, s[kb], 0, 0, 0); } }
        if (t == 4) { s[1] = (f32x4){-1e30f, -1e30f, -1e30f, -1e30f}; s[2] = s[1]; s[3] = s[1]; }
        float rm = __builtin_fmaxf(__builtin_fmaxf(s[0][0], s[0][1]), __builtin_fmaxf(s[0][2], s[0][3]));
#pragma unroll
        for (int kb = 1; kb < 4; ++kb) rm = __builtin_fmaxf(rm, __builtin_fmaxf(__builtin_fmaxf(s[kb][0], s[kb][1]), __builtin_fmaxf(s[kb][2], s[kb][3])));
        rm = __builtin_fmaxf(rm, __shfl_xor(rm, 16)); rm = __builtin_fmaxf(rm, __shfl_xor(rm, 32));
        const float mn = __builtin_fmaxf(m, rm), f = __builtin_amdgcn_exp2f(m - mn); m = mn;
        float ls = 0.f;
#pragma unroll
        for (int kb = 0; kb < 4; ++kb)
#pragma unroll
            for (int i = 0; i < 4; ++i) { s[kb][i] = __builtin_amdgcn_exp2f(s[kb][i] - mn); ls += s[kb][i]; }
        l = l * f + ls;
#pragma unroll
        for (int cb = 0; cb < 16; ++cb) o[cb] *= f;
        u32x4 pw[2];
#pragma unroll
        for (int s2 = 0; s2 < 2; ++s2) pw[s2] = (u32x4){cvtpk_s(s[2 * s2][0], s[2 * s2][1]), cvtpk_s(s[2 * s2][2], s[2 * s2][3]), cvtpk_s(s[2 * s2 + 1][0], s[2 * s2 + 1][1]), cvtpk_s(s[2 * s2 + 1][2], s[2 * s2 + 1][3])};
#pragma unroll
        for (int cb = 0; cb < 16; ++cb)
#pragma unroll
            for (int s2 = 0; s2 < 2; ++s2) { const lptr va = KTp + (32 * s2 + 4 * g + (fr >> 2)) * DQS + (16 * cb + 4 * (fr & 3)) * 2;
                const s16x4 lo = __builtin_bit_cast(s16x4, __builtin_amdgcn_ds_read_tr16_b64_v4i16((LAS v4i16_t*)va));
                const s16x4 hh = __builtin_bit_cast(s16x4, __builtin_amdgcn_ds_read_tr16_b64_v4i16((LAS v4i16_t*)(va + 16 * DQS)));
                const bf16x8 vf = {lo[0], lo[1], lo[2], lo[3], hh[0], hh[1], hh[2], hh[3]};
                o[cb] = __builtin_amdgcn_mfma_f32_16x16x32_bf16(vf, __builtin_bit_cast(bf16x8, pw[s2]), o[cb], 0, 0, 0); }
        __syncthreads();
        if (t + 1 < NT) {
            if (t + 1 < 4) { DEC_STORE(); }
            else {
                for (int idx = tid; idx < 16 * 36; idx += 512) { const int key = idx / 36, ch = idx - key * 36; const size_t row = (size_t)TP + b * SSEQ + key;
                    const u32x4 v = (ch < 32) ? *(const u32x4*)(CKVN + row * KVL + ch * 8) : *(const u32x4*)(KPE + row * RD + (ch - 32) * 8);
                    *(LAS u32x4*)(KTp + key * DQS + ch * 16) = v; }
                for (int idx = tid; idx < 48 * 37; idx += 512) { const int key = 16 + idx / 37, ch = idx % 37; *(LAS u32x4*)(KTp + key * DQS + ch * 16) = (u32x4){0u, 0u, 0u, 0u}; }
            }
        }
        __syncthreads();
    }
    l += __shfl_xor(l, 16); l += __shfl_xor(l, 32);
    f32x4 y[4];
#pragma unroll
    for (int db = 0; db < 4; ++db) y[db] = (f32x4){0.f, 0.f, 0.f, 0.f};
#pragma unroll
    for (int ks = 0; ks < 8; ++ks) { const u32x4 ob = {cvtpk_s(o[2 * ks][0], o[2 * ks][1]), cvtpk_s(o[2 * ks][2], o[2 * ks][3]), cvtpk_s(o[2 * ks + 1][0], o[2 * ks + 1][1]), cvtpk_s(o[2 * ks + 1][2], o[2 * ks + 1][3])};
#pragma unroll
        for (int db = 0; db < 4; ++db) { const bf16* wrow = Wkv_t + (size_t)(512 + 64 * w + 16 * db + fr) * KVL + 32 * ks + 4 * g;
            const u32x2 w0 = *(const u32x2*)wrow, w1 = *(const u32x2*)(wrow + 16); const u32x4 wa = {w0.x, w0.y, w1.x, w1.y};
            y[db] = __builtin_amdgcn_mfma_f32_16x16x32_bf16(__builtin_bit_cast(bf16x8, wa), __builtin_bit_cast(bf16x8, ob), y[db], 0, 0, 0); } }
    const size_t prow = ((size_t)(b * 16 + sp) * 128 + 16 * w + fr);
#pragma unroll
    for (int db = 0; db < 4; ++db) *(f32x4*)(PART + prow * 64 + 16 * db + 4 * g) = y[db];
    if (g == 0) { ML[prow * 2] = m; ML[prow * 2 + 1] = l; }
#undef DEC_LOAD
#undef DEC_STORE
}

constexpr int M_UH = 0, M_WDW = 62 * 1024, M_END = M_WDW + 31 * 2048;
template <int NR, bool COMBINE> __device__ __forceinline__ void mix_rows(lptr UH, const LAS float* WDW, int lrow0, size_t grow0, const float* bdw, const float* gcn, const float* bcn,
                                                           const bf16* __restrict__ OMLA, bf16* MIX, int lane, const float* PART = nullptr, const float* ML = nullptr) {
    u32x4 om[NR];
#pragma unroll
    for (int r = 0; r < NR; ++r) om[r] = COMBINE ? (u32x4){0u, 0u, 0u, 0u} : *(const u32x4*)(OMLA + (grow0 + r) * 512 + 8 * lane);
    float acc[NR][8];
#pragma unroll
    for (int r = 0; r < NR; ++r)
#pragma unroll
        for (int e = 0; e < 8; ++e) acc[r][e] = bdw[e];
    f32x4 wl[NR][2];
#pragma unroll
    for (int r = 0; r < NR; ++r) { wl[r][0] = (f32x4){0.f, 0.f, 0.f, 0.f}; wl[r][1] = wl[r][0]; }
#pragma unroll 1
    for (int i0 = 0; i0 < NR + CW - 1; i0 += NR) {
#pragma unroll
        for (int ii = 0; ii < NR; ++ii) { const int i = i0 + ii; const int iw = i < CW ? i : CW - 1, iu = i < NR + CW - 1 ? i : NR + CW - 2;
            const f32x4 wa_ = *(const LAS f32x4*)(WDW + iw * 512 + 8 * lane), wb_ = *(const LAS f32x4*)(WDW + iw * 512 + 8 * lane + 4);
            const float keep = i < CW ? 1.0f : 0.0f; wl[ii][0] = wa_ * keep; wl[ii][1] = wb_ * keep;
            const u32x4 uv = *(const LAS u32x4*)(UH + (lrow0 + iu) * 1024 + 16 * lane);
            const float f0 = __uint_as_float(uv.x << 16), f1 = __uint_as_float(uv.x & 0xffff0000u), f2 = __uint_as_float(uv.y << 16), f3 = __uint_as_float(uv.y & 0xffff0000u),
                        f4 = __uint_as_float(uv.z << 16), f5 = __uint_as_float(uv.z & 0xffff0000u), f6 = __uint_as_float(uv.w << 16), f7 = __uint_as_float(uv.w & 0xffff0000u);
#pragma unroll
            for (int r = 0; r < NR; ++r) { const f32x4 wa = wl[(ii - r + NR) % NR][0], wb = wl[(ii - r + NR) % NR][1];
                acc[r][0] += f0 * wa[0]; acc[r][1] += f1 * wa[1]; acc[r][2] += f2 * wa[2]; acc[r][3] += f3 * wa[3];
                acc[r][4] += f4 * wb[0]; acc[r][5] += f5 * wb[1]; acc[r][6] += f6 * wb[2]; acc[r][7] += f7 * wb[3]; } }
    }
#pragma unroll
    for (int r = 0; r < NR; ++r) {
        float s = 0.f;
#pragma unroll
        for (int e = 0; e < 8; ++e) s += acc[r][e];
        const float mu = wave_sum(s) * (1.0f / CC);
        float q = 0.f;
#pragma unroll
        for (int e = 0; e < 8; ++e) { acc[r][e] -= mu; q += acc[r][e] * acc[r][e]; }
        const float rs = rsqrtf(wave_sum(q) * (1.0f / CC) + EPS);
        float q2 = 0.f;
#pragma unroll
        for (int e = 0; e < 8; ++e) { const float ln = acc[r][e] * rs * gcn[e] + bcn[e]; const float co = ln * __builtin_amdgcn_rcpf(1.f + __builtin_amdgcn_exp2f(-1.4426950408889634f * ln)); acc[r][e] = co; q2 += co * co; }
        const float r2 = rsqrtf(wave_sum(q2) * (1.0f / CC) + EPS);
        const size_t row = grow0 + r;
        u32x4 ov; ov.x = cvtpk_s(acc[r][0] * r2, acc[r][1] * r2); ov.y = cvtpk_s(acc[r][2] * r2, acc[r][3] * r2); ov.z = cvtpk_s(acc[r][4] * r2, acc[r][5] * r2); ov.w = cvtpk_s(acc[r][6] * r2, acc[r][7] * r2);
        *(u32x4*)(MIX + row * DM + 512 + 8 * lane) = ov;
        float x[8];
        if constexpr (COMBINE) { const int srow = (int)(row - TP), bb = srow >> 4, tok = srow & 15, hh = lane >> 3, d0 = 8 * (lane & 7);
            float mv[16], lv[16], M = -1e30f;
#pragma unroll
            for (int s2 = 0; s2 < 16; ++s2) { const size_t pr = ((size_t)(bb * 16 + s2) * 128 + 16 * hh + tok); mv[s2] = ML[pr * 2]; lv[s2] = ML[pr * 2 + 1]; M = __builtin_fmaxf(M, mv[s2]); }
            f32x4 a0 = {0.f, 0.f, 0.f, 0.f}, a1 = a0; float L = 0.f;
#pragma unroll
            for (int sh = 0; sh < 2; ++sh) {
#pragma unroll
                for (int s3 = 0; s3 < 8; ++s3) { const int s2 = 8 * sh + s3; const size_t pr = ((size_t)(bb * 16 + s2) * 128 + 16 * hh + tok); const float wgt = __builtin_amdgcn_exp2f(mv[s2] - M);
                    L += wgt * lv[s2]; a0 += *(const f32x4*)(PART + pr * 64 + d0) * wgt; a1 += *(const f32x4*)(PART + pr * 64 + d0 + 4) * wgt; }
                asm volatile("" ::: "memory"); }
            const float rl = 1.0f / L;
            x[0] = a0[0] * rl; x[1] = a0[1] * rl; x[2] = a0[2] * rl; x[3] = a0[3] * rl; x[4] = a1[0] * rl; x[5] = a1[1] * rl; x[6] = a1[2] * rl; x[7] = a1[3] * rl;
        } else { const u32x4 o4 = om[r];
            x[0] = __uint_as_float(o4.x << 16); x[1] = __uint_as_float(o4.x & 0xffff0000u); x[2] = __uint_as_float(o4.y << 16); x[3] = __uint_as_float(o4.y & 0xffff0000u);
            x[4] = __uint_as_float(o4.z << 16); x[5] = __uint_as_float(o4.z & 0xffff0000u); x[6] = __uint_as_float(o4.w << 16); x[7] = __uint_as_float(o4.w & 0xffff0000u); }
        float q3 = 0.f;
#pragma unroll
        for (int e = 0; e < 8; ++e) q3 += x[e] * x[e];
        const float r3 = rsqrtf(wave_sum(q3) * (1.0f / 512.0f) + EPS);
        u32x4 o2; o2.x = cvtpk_s(x[0] * r3, x[1] * r3); o2.y = cvtpk_s(x[2] * r3, x[3] * r3); o2.z = cvtpk_s(x[4] * r3, x[5] * r3); o2.w = cvtpk_s(x[6] * r3, x[7] * r3);
        *(u32x4*)(MIX + row * DM + 8 * lane) = o2;
    }
}
#undef SBAR
}

constexpr int NWAVES = 8;
#ifndef MK_N_LAUNCHES
#define MK_N_LAUNCHES 1
#endif
constexpr int NPHASE = 11;
#ifndef MK_DUP
#define MK_DUP 0
#endif
constexpr int N_LAUNCHES = MK_N_LAUNCHES;

constexpr size_t MiB = 1u << 20;
constexpr size_t WS_CTL = 0, CTL_ZERO_BYTES = 512 * 1024;
constexpr size_t WS_W1 = 1 * MiB, WS_WQ = 5 * MiB, WS_WKV = 6 * MiB, WS_WO = 7 * MiB, WS_WGU = 9 * MiB, WS_WD = 20 * MiB, WS_WUKN = 25 * MiB + 512 * 1024, WS_ROPE = 26 * MiB;
constexpr size_t WS_XN = 27 * MiB, WS_MIX = WS_XN, WS_CQ = 60 * MiB, WS_CKVN = 73 * MiB, WS_KPE = 82 * MiB, WS_U = 84 * MiB, WS_Q = 101 * MiB, WS_ACT = 27 * MiB;
constexpr size_t WS_H2 = 126 * MiB;
constexpr size_t WS_SLAB6 = 208 * MiB, WS_SLAB8 = 212 * MiB;
constexpr int MT6 = 4, MT8 = 4;
constexpr size_t WS_KN = 126 * MiB, WS_V = 142 * MiB, WS_OMLA = 158 * MiB, WS_HB = 175 * MiB, WS_PART = 208 * MiB, WS_ML = 240 * MiB, WS_END = 241 * MiB;
static_assert(WS_W1 + (size_t)N1 * DM * 2 <= WS_WQ && WS_WQ + (size_t)NQ * QL * 2 <= WS_WKV && WS_WKV + (size_t)NKV * KVL * 2 <= WS_WO && WS_WO + (size_t)DM * DM * 2 <= WS_WGU &&
              WS_WGU + (size_t)NGU * DM * 2 <= WS_WD && WS_WD + (size_t)DM * DFF * 2 <= WS_WUKN && WS_WUKN + (size_t)KVL * 512 * 2 <= WS_ROPE && WS_ROPE + (size_t)NPOS * 16 * 8 <= WS_XN, "weight map");
static_assert(WS_XN + (size_t)T * DM * 2 <= WS_CQ && WS_CQ + (size_t)T * QL * 2 <= WS_CKVN && WS_CKVN + (size_t)T * KVL * 2 <= WS_KPE && WS_KPE + (size_t)T * RD * 2 <= WS_U &&
              WS_U + (size_t)T * CC * 2 <= WS_Q && WS_Q + (size_t)T * NQ * 2 <= WS_KN && WS_ACT + (size_t)T * DFF * 2 <= WS_KN && WS_KN + (size_t)TP * 512 * 2 <= WS_V &&
              WS_V + (size_t)TP * 512 * 2 <= WS_OMLA && WS_OMLA + (size_t)T * 512 * 2 <= WS_HB && WS_HB + (size_t)T * DM * 2 <= WS_PART && WS_PART + (size_t)256 * 128 * 256 * 4 <= WS_ML &&
              WS_ML + (size_t)256 * 128 * 2 * 4 <= WS_END, "activation map");
constexpr int CW_TMO = 0, CW_CODE = 1, CW_BAR = 4096, CW_CNT6 = 8192, CW_SSQ_Q = 16384, CW_SSQ_H = CW_SSQ_Q + T;
static_assert((size_t)(CW_SSQ_H + T) * 4 <= CTL_ZERO_BYTES, "CTL words inside the memset region");
constexpr int RING_OFF = 0, RING_BYTES = 131072, EX_OFF = RING_BYTES, LDSCTL_OFF = EX_OFF + 4096, MISC_OFF = LDSCTL_OFF + 320, LDS_BYTES = 147456;
static_assert(MISC_OFF + 128 <= LDS_BYTES && att::L_END <= RING_BYTES && att::D_END <= RING_BYTES && att::M_END <= RING_BYTES, "LDS map");

typedef unsigned short bf16;
typedef unsigned v4u __attribute__((ext_vector_type(4)));
typedef float f32x4 __attribute__((ext_vector_type(4)));
typedef GAS unsigned gu32;
#define RLX_AGENT __ATOMIC_RELAXED, __HIP_MEMORY_SCOPE_AGENT
#define LDS_WAIT() asm volatile("s_waitcnt lgkmcnt(0)" ::: "memory")
#define VM_WAIT() asm volatile("s_waitcnt vmcnt(0)" ::: "memory")
__device__ __forceinline__ unsigned f2bf(float f) { unsigned u = __builtin_bit_cast(unsigned, f); return (u + 0x7fffu + ((u >> 16) & 1u)) >> 16; }
__device__ __forceinline__ unsigned pk2(float lo, float hi) { return f2bf(lo) | (f2bf(hi) << 16); }

#define XB_TMO      128
#define XB_XCNT(j)  (256  + 64 * (j))
#define XB_XSUB(j)  (1280 + 64 * (j))
#define XB_XGEN(j)  (2304 + 64 * (j))
#define XB_TOP      3328
#define XB_TOPGEN   3392
#define XCD_BAR_WORDS 3456
#define XB_SPIN_CAP (1u << 18)

__device__ __forceinline__ unsigned xb_ld(unsigned* p)              { return __hip_atomic_load(p, __ATOMIC_RELAXED, __HIP_MEMORY_SCOPE_AGENT); }
__device__ __forceinline__ unsigned xb_add(unsigned* p, unsigned v) { return __hip_atomic_fetch_add(p, v, __ATOMIC_RELAXED, __HIP_MEMORY_SCOPE_AGENT); }
__device__ __forceinline__ unsigned xb_xcc_id() { return (unsigned)__builtin_amdgcn_s_getreg((3 << 11) | 20) & 0xFu; }
#define XB_SPIN(cond, bar) do { unsigned _sp = 0; while (cond) { __builtin_amdgcn_s_sleep(1); \
    if ((++_sp & 255u) == 0u) { if (xb_ld(&(bar)[XB_TMO])) break; if (_sp > XB_SPIN_CAP) { atomicAdd(&(bar)[XB_TMO], 1u); break; } } } } while (0)

struct XcdBarrier {
    unsigned* bar; unsigned x;
    volatile LAS unsigned* st;
};

__device__ __forceinline__ XcdBarrier xcd_barrier_post(unsigned* bar, volatile LAS unsigned* st) {
    XcdBarrier b; b.bar = bar; b.x = xb_xcc_id(); b.st = st;
    if (threadIdx.x == 0) (void)xb_add(&bar[XB_XCNT(b.x)], 1u);
    return b;
}
__device__ __forceinline__ void xcd_barrier_complete(unsigned* bar, unsigned x, unsigned& nloc, unsigned& nx) {
    const unsigned G = gridDim.x * gridDim.y * gridDim.z;
    unsigned sum, cnt, mine, sp = 0u;
    for (;;) {
        sum = 0u; cnt = 0u; mine = 0u;
#pragma unroll
        for (unsigned j = 0; j < 16; ++j) { const unsigned c = xb_ld(&bar[XB_XCNT(j)]); sum += c; cnt += (c > 0u) ? 1u : 0u; mine = (j == x) ? c : mine; }
        if (sum == G) break;
        __builtin_amdgcn_s_sleep(1);
        if ((++sp & 255u) == 0u) { if (xb_ld(&bar[XB_TMO])) break; if (sp > XB_SPIN_CAP) { atomicAdd(&bar[XB_TMO], 1u); break; } }
    }
    nloc = mine > 0u ? mine : 1u; nx = cnt > 0u ? cnt : 1u;
}

__device__ __forceinline__ void xcd_barrier(const XcdBarrier& b) {
    asm volatile("s_waitcnt vmcnt(0)" ::: "memory");
    __syncthreads();
    if (threadIdx.x == 0) {
        unsigned* bar = b.bar;
        __builtin_amdgcn_s_waitcnt(0);
        unsigned nloc = b.st[0], nx = b.st[1];
        if (nloc == 0u) { xcd_barrier_complete(bar, b.x, nloc, nx); b.st[0] = nloc; b.st[1] = nx; }
        const unsigned old = xb_add(&bar[XB_XSUB(b.x)], 1u);
        const unsigned gen = old / nloc;
        if (old + 1u == (gen + 1u) * nloc) {
            __builtin_amdgcn_fence(__ATOMIC_RELEASE, "agent");
            asm volatile("s_waitcnt vmcnt(0)" ::: "memory");
            const unsigned og = xb_add(&bar[XB_TOP], 1u);
            const unsigned tg = og / nx;
            if (og + 1u == (tg + 1u) * nx) xb_add(&bar[XB_TOPGEN], 1u);
            else XB_SPIN(xb_ld(&bar[XB_TOPGEN]) == tg, bar);
            __builtin_amdgcn_fence(__ATOMIC_ACQUIRE, "agent");
            xb_add(&bar[XB_XGEN(b.x)], 1u);
            asm volatile("s_waitcnt vmcnt(0)" ::: "memory");
        } else {
            XB_SPIN(xb_ld(&bar[XB_XGEN(b.x)]) == gen, bar);
            __builtin_amdgcn_fence(__ATOMIC_ACQUIRE, "agent");
            asm volatile("s_waitcnt vmcnt(0)" ::: "memory");
        }
    }
    __syncthreads();
}


template <class Src> __device__ __forceinline__ void p0_transpose_item(const Src& S, int K, bf16* WT, LAS float* scr, int item, int lane) {
    const int nblk = Src::N / 32, kb = item / nblk, nb = item % nblk, k0 = 64 * kb, n0 = 32 * nb;
#pragma unroll 8
    for (int i = 0; i < 32; ++i) { const int kk = 2 * i + (lane >> 5); scr[kk * 33 + (lane & 31)] = S.load(k0 + kk, n0 + (lane & 31)); }
    LDS_WAIT(); asm volatile("" ::: "memory");
    const int c = lane & 7;
#pragma unroll
    for (int j = 0; j < 4; ++j) { const int n = (lane >> 3) + 8 * j; const LAS float* s = scr + (8 * c) * 33 + n;
        v4u o; o.x = pk2(s[0 * 33], s[1 * 33]); o.y = pk2(s[2 * 33], s[3 * 33]); o.z = pk2(s[4 * 33], s[5 * 33]); o.w = pk2(s[6 * 33], s[7 * 33]);
        *(GAS v4u*)(WT + (size_t)(n0 + n) * K + k0 + 8 * c) = o; }
    LDS_WAIT(); asm volatile("" ::: "memory");
}
struct SrcW1 { static constexpr int N = N1; const float* w;
    __device__ __forceinline__ float load(int k, int n) const { int col;
        if (n < 256) col = QL + n;
        else if (n < 640) col = n - 256;
        else if (n < 672) { const int p = n - 640; col = QL + KVL + ((p >> 2) & 1) * 16 + 4 * (p >> 3) + (p & 3); }
        else if (n < 768) return 0.f;
        else { const int q = (n - 768) & 255, t = (n - 768) >> 8; col = QL + KVL + RD + ((q >> 7) ? CC : 0) + 128 * t + (q & 127); }
        return w[(size_t)k * INW + col]; } };
struct SrcWq { static constexpr int N = NQ; const float* w; const float* g;
    __device__ __forceinline__ float load(int k, int n) const { const int h = n / 96, r = n - h * 96; int col = h * 96 + r;
        if (r >= 64) { const int p = r - 64; col = h * 96 + 64 + ((p >> 2) & 1) * 16 + 4 * (p >> 3) + (p & 3); }
        return w[(size_t)k * NQ + col] * g[k]; } };
struct SrcWkv { static constexpr int N = NKV; const float* w;
    __device__ __forceinline__ float load(int k, int n) const { return w[(size_t)k * 512 + (n & 511)]; } };
struct SrcWo { static constexpr int N = DM; const float* w; const float* g;
    __device__ __forceinline__ float load(int k, int n) const { return w[(size_t)k * DM + n] * g[k & 511]; } };
struct SrcWgu { static constexpr int N = NGU; const float* w; const float* ln;
    __device__ __forceinline__ float load(int k, int n) const { const int t = n >> 8, q = n & 255, j = 128 * t + (q & 127); return w[(size_t)k * DFF + j] * ln[k]; } };
struct SrcWd { static constexpr int N = DM; const float* w;
    __device__ __forceinline__ float load(int k, int n) const { return w[(size_t)k * DM + n]; } };

__device__ __forceinline__ void rms_row(const float* xrow, const float* g, bf16* out_bf, float* out_f32, int lane, const float* slab = nullptr, int nslab = 0, const bf16* hbrow = nullptr) {
    const GAS f32x4* xr = (const GAS f32x4*)xrow + lane; const GAS f32x4* gr = (const GAS f32x4*)g + lane;
    f32x4 v[4]; float s = 0.f;
    if (hbrow) {
#pragma unroll
        for (int j = 0; j < 4; ++j) { const unsigned long long h = ((const GAS unsigned long long*)hbrow + lane)[64 * j]; const unsigned lo = (unsigned)h, hi = (unsigned)(h >> 32);
            v[j] = (f32x4){__uint_as_float(lo << 16), __uint_as_float(lo & 0xffff0000u), __uint_as_float(hi << 16), __uint_as_float(hi & 0xffff0000u)}; }
    } else {
#pragma unroll
        for (int j = 0; j < 4; ++j) v[j] = xr[64 * j];
    }
    if (slab) for (int sl = 0; sl < nslab; ++sl) { const GAS f32x4* sr = (const GAS f32x4*)(slab + (size_t)sl * 256 * DM) + lane;
#pragma unroll
        for (int j = 0; j < 4; ++j) v[j] += sr[64 * j]; }
#pragma unroll
    for (int j = 0; j < 4; ++j) s += (v[j].x * v[j].x + v[j].y * v[j].y) + (v[j].z * v[j].z + v[j].w * v[j].w);
    const float r = rsqrtf(att::wave_sum(s) * (1.0f / DM) + EPS);
#pragma unroll
    for (int j = 0; j < 4; ++j) { const f32x4 o = v[j] * r * gr[64 * j];
        if (out_bf) { GAS unsigned long long* o8 = (GAS unsigned long long*)out_bf + lane; o8[64 * j] = (unsigned long long)pk2(o.x, o.y) | ((unsigned long long)pk2(o.z, o.w) << 32); }
        else ((GAS f32x4*)out_f32 + lane)[64 * j] = o; }
}

struct Args { const float* in[24]; float* out; unsigned char* ws; int ph_lo, ph_hi; };
__global__ void __launch_bounds__(NWAVES * 64, 2) mk_fwd(Args args) {
    extern __shared__ __attribute__((aligned(16))) unsigned char lds[];
    LAS unsigned char* const ldsp = (LAS unsigned char*)lds;
    volatile LAS unsigned* const MISC = (volatile LAS unsigned*)(ldsp + MISC_OFF);
    const int tid0 = threadIdx.x, wave = __builtin_amdgcn_readfirstlane(tid0 >> 6);
#define PHASE_IDS() int tid = tid0; asm volatile("" : "+v"(tid)); const int lane = tid & 63; const int gtid = (int)blockIdx.x * (NWAVES * 64) + tid; (void)lane; (void)gtid
    const int G = gridDim.x; const int vcu = (G % 8 == 0) ? ((int)blockIdx.x % 8) * (G / 8) + (int)blockIdx.x / 8 : (int)blockIdx.x;
    unsigned char* const ws = args.ws; float* const out = args.out;
    gu32* const ctl = (gu32*)(ws + WS_CTL);
    const float *x_p = args.in[0], *x_s = args.in[1], *cache_kv = args.in[2], *cache_kr = args.in[3], *st_conv = args.in[4], *ln_mix = args.in[5], *w_in = args.in[6], *g_q = args.in[7],
                *w_uq = args.in[8], *g_kv = args.in[9], *w_uk = args.in[10], *w_uv = args.in[11], *w_dw = args.in[12], *b_dw = args.in[13], *g_cn = args.in[14], *b_cn = args.in[15],
                *g_om = args.in[16], *g_oc = args.in[17], *w_out = args.in[18], *ln_ffn = args.in[19], *w_gate = args.in[20], *w_up = args.in[21], *w_down = args.in[22], *g_final = args.in[23];
    bf16 *W1t = (bf16*)(ws + WS_W1), *Wq_t = (bf16*)(ws + WS_WQ), *Wkv_t = (bf16*)(ws + WS_WKV), *Wo_t = (bf16*)(ws + WS_WO), *Wgu_t = (bf16*)(ws + WS_WGU), *Wd_t = (bf16*)(ws + WS_WD), *WUKn = (bf16*)(ws + WS_WUKN);
    float* ROPE = (float*)(ws + WS_ROPE);
    bf16 *XN = (bf16*)(ws + WS_XN), *MIX = (bf16*)(ws + WS_MIX), *CQ = (bf16*)(ws + WS_CQ), *CKVN = (bf16*)(ws + WS_CKVN), *KPE = (bf16*)(ws + WS_KPE), *U = (bf16*)(ws + WS_U), *Q = (bf16*)(ws + WS_Q),
         *ACT = (bf16*)(ws + WS_ACT), *KN = (bf16*)(ws + WS_KN), *V = (bf16*)(ws + WS_V), *OMLA = (bf16*)(ws + WS_OMLA), *HB = (bf16*)(ws + WS_HB);
    float *PART = (float*)(ws + WS_PART), *ML = (float*)(ws + WS_ML), *SSQ_Q = (float*)(ws + WS_CTL) + CW_SSQ_Q, *SSQ_H = (float*)(ws + WS_CTL) + CW_SSQ_H, *Y = out + O_Y;

    for (int u = tid0; u < (LDS_BYTES - LDSCTL_OFF) / 4; u += NWAVES * 64) ((LAS unsigned*)(ldsp + LDSCTL_OFF))[u] = 0u;
    __syncthreads();
    XcdBarrier bar; bar.bar = (unsigned*)(ctl + CW_BAR); bar.x = 0; bar.st = nullptr;
    if (N_LAUNCHES != NPHASE) bar = xcd_barrier_post((unsigned*)(ctl + CW_BAR), MISC + 8);
#define GRID_BAR() do { if (N_LAUNCHES == NPHASE) { if (tid0 == 0) __hip_atomic_store(ctl + CW_TMO, 0xBADBA0u, RLX_AGENT); } else { xcd_barrier(bar); } } while (0)
    const int lo = args.ph_lo, hi = args.ph_hi;
#define IN(k) (lo <= (k) && (k) < hi)
#define BOTH(k) (IN(k) && IN((k) + 1))
    const int gw = vcu * NWAVES + wave, NGW = G * NWAVES, NGT = G * NWAVES * 64;

    for (int rep_ = 0; rep_ < 1 + ((MK_DUP >> 0) & 1); ++rep_)
    if (IN(0)) {
        PHASE_IDS();
        LAS float* scr = (LAS float*)(ldsp + RING_OFF + wave * 16384);
        constexpr int I_1 = (DM / 64) * (N1 / 32), I_Q = (QL / 64) * (NQ / 32), I_KV = (KVL / 64) * (NKV / 32), I_O = (DM / 64) * (DM / 32), I_GU = (DM / 64) * (NGU / 32), I_D = (DFF / 64) * (DM / 32);
        constexpr int NITEMS = I_1 + I_Q + I_KV + I_O + I_GU + I_D;
        for (int it = gw; it < NITEMS; it += NGW) {
            int r = it;
            if (r < I_1) { p0_transpose_item(SrcW1{w_in}, DM, W1t, scr, r, lane); continue; } r -= I_1;
            if (r < I_Q) { p0_transpose_item(SrcWq{w_uq, g_q}, QL, Wq_t, scr, r, lane); continue; } r -= I_Q;
            if (r < I_KV) { const bool second = (r % (NKV / 32)) * 32 >= 512; p0_transpose_item(SrcWkv{second ? w_uv : w_uk}, KVL, Wkv_t, scr, r, lane); continue; } r -= I_KV;
            if (r < I_O) { const bool second = (r / (DM / 32)) * 64 >= 512; p0_transpose_item(SrcWo{w_out, second ? g_oc : g_om}, DM, Wo_t, scr, r, lane); continue; } r -= I_O;
            if (r < I_GU) { const bool up = (((r % (NGU / 32)) * 32) & 255) >= 128; p0_transpose_item(SrcWgu{up ? w_up : w_gate, ln_ffn}, DM, Wgu_t, scr, r, lane); continue; } r -= I_GU;
            p0_transpose_item(SrcWd{w_down}, DFF, Wd_t, scr, r, lane);
        }
        for (int m = gw; m < T; m += NGW) rms_row(m < TP ? x_p + (size_t)m * DM : x_s + (size_t)(m - TP) * DM, ln_mix, XN + (size_t)m * DM, nullptr, lane);
        for (int i = gtid; i < NPOS * 16; i += NGT) { const int pi = i >> 4, fi = i & 15; const int pos = pi < SEQ ? pi : PAST + (pi - SEQ);
            const double ang = (double)pos * exp2(-(double)fi * 0.8304820237218406);
            ROPE[2 * i] = (float)cos(ang); ROPE[2 * i + 1] = (float)sin(ang); }
        for (int i = gtid; i < KVL * 512 / 4; i += NGT) { const f32x4 v = *(const f32x4*)(w_uk + (size_t)i * 4); *(unsigned long long*)(WUKn + (size_t)i * 4) = (unsigned long long)pk2(v.x, v.y) | ((unsigned long long)pk2(v.z, v.w) << 32); }
        for (int i = gtid; i < SBATCH * (CST - SSEQ) * CC / 4; i += NGT) { const int c4 = i % (CC / 4), r = (i / (CC / 4)) % (CST - SSEQ), b = i / ((CC / 4) * (CST - SSEQ));
            *(f32x4*)(out + O_CVS + ((size_t)b * CST + r) * CC + c4 * 4) = *(const f32x4*)(st_conv + ((size_t)b * CST + SSEQ + r) * CC + c4 * 4); }
        if (BOTH(0)) GRID_BAR();
        if ((MK_DUP >> 20) & 1) { GRID_BAR(); GRID_BAR(); GRID_BAR(); GRID_BAR(); }
    }
    if (IN(1)) {
        pg8::Gemm g{XN, W1t, T, N1, DM}; pg8::StaticOrder S; S.init(T, N1, G, (int)blockIdx.x);
        if ((MK_DUP >> 1) & 1) { pg8::EpiProj Ed{CKVN, CQ, KPE, U, out, (float*)(ws + WS_ML), g_kv, ROPE, (LAS float*)(ldsp + EX_OFF)};
            pg8::gemm_phase<pg8::EpiProj, pg8::StaticOrder, true, true>(ldsp + RING_OFF, g, S, Ed); GRID_BAR(); }
        pg8::EpiProj E{CKVN, CQ, KPE, U, out, SSQ_Q, g_kv, ROPE, (LAS float*)(ldsp + EX_OFF)};
        pg8::gemm_phase<pg8::EpiProj, pg8::StaticOrder, true, true>(ldsp + RING_OFF, g, S, E);
        if (BOTH(1)) GRID_BAR();
    }
    for (int rep_ = 0; rep_ < 1 + ((MK_DUP >> 2) & 1); ++rep_)
    if (IN(2)) {
        { pg8::Gemm g{CQ, Wq_t, T, NQ, QL}; pg8::StaticOrder S; S.init(T, NQ, G, (int)blockIdx.x);
          pg8::EpiQ E{Q, SSQ_Q, ROPE};
          pg8::gemm_phase<pg8::EpiQ, pg8::StaticOrder, true, true>(ldsp + RING_OFF, g, S, E); }
        { pg8::Gemm g{CKVN, Wkv_t, TP, NKV, KVL}; pg8::StaticOrder S; S.init(TP, NKV, G, (int)blockIdx.x);
          pg8::EpiBf16 E{KN, 512, 512, (size_t)(WS_V - WS_KN) / 2};
          pg8::gemm_phase<pg8::EpiBf16, pg8::StaticOrder, true, true>(ldsp + RING_OFF, g, S, E); }
        if (BOTH(2)) GRID_BAR();
    }
    for (int rep_ = 0; rep_ < 1 + ((MK_DUP >> 3) & 1); ++rep_)
    if (IN(3)) {
        PHASE_IDS();
        if (rep_ == 0 || ((MK_DUP >> 16) & 1) == 0) for (int p = vcu; p < 256; p += G) { const int bh = p >> 2, s = p & 3;
            att::prompt_unit(bh >> 3, bh & 7, 7 - s, Q, KN, KPE, V, OMLA, (char*)lds + RING_OFF);
            att::prompt_unit(bh >> 3, bh & 7, s, Q, KN, KPE, V, OMLA, (char*)lds + RING_OFF); }
        if (rep_ == 0 || ((MK_DUP >> 17) & 1) == 0) for (int p = vcu; p < 256; p += G) att::decode_unit(p >> 4, p & 15, Q, WUKn, cache_kv, cache_kr, CKVN, KPE, Wkv_t, PART, ML, (att::lptr)(ldsp + RING_OFF));
        if (IN(3) && IN(5)) GRID_BAR();
    }
    for (int rep_ = 0; rep_ < 1 + ((MK_DUP >> 5) & 1); ++rep_)
    if (IN(5)) {
        PHASE_IDS();
        const att::lptr UH = (att::lptr)(ldsp + RING_OFF + att::M_UH); LAS float* WDW = (LAS float*)(ldsp + RING_OFF + att::M_WDW);
        __syncthreads();
        { f32x4 tw[8];
#pragma unroll
          for (int k = 0; k < 8; ++k) { const int i = tid + 512 * k; tw[k] = *(const f32x4*)(w_dw + 4 * (i < CW * CC / 4 ? i : 0)); }
#pragma unroll
          for (int k = 0; k < 8; ++k) { const int i = tid + 512 * k; if (i < CW * CC / 4) *(LAS f32x4*)(WDW + 4 * i) = tw[k]; } }
        float bdw[8], gcn[8], bcn[8];
#pragma unroll
        for (int e = 0; e < 8; ++e) { bdw[e] = b_dw[8 * lane + e]; gcn[e] = g_cn[8 * lane + e]; bcn[e] = b_cn[8 * lane + e]; }
        const bool prun = (rep_ == 0) && ((MK_DUP >> 5) & 1);
        const bool p_nofill = prun && ((MK_DUP >> 22) & 1), p_nocomp = prun && ((MK_DUP >> 23) & 1);
        for (int it = (prun && ((MK_DUP >> 19) & 1)) ? vcu + 512 : vcu; it < ((prun && ((MK_DUP >> 18) & 1)) ? 512 : 512 + SBATCH); it += G) {
            __syncthreads();
            if (it < 512) { const int r0 = it * 32, b = r0 >> 11, s0 = r0 & (SEQ - 1);
                v4u tmp[8];
                if (!p_nofill) {
#pragma unroll
                for (int k = 0; k < 8; ++k) { const int i = tid + 512 * k, lr = (i >> 6) < 61 ? (i >> 6) : 61, ch = i & 63, s = s0 - CST + lr;
                    const v4u v = *(const v4u*)(U + ((size_t)b * SEQ + (s >= 0 ? s : 0)) * CC + ch * 8); tmp[k] = (s >= 0) ? v : (v4u){0u, 0u, 0u, 0u}; } }
#pragma unroll
                for (int k = 0; k < 8; ++k) { const int i = tid + 512 * k; if (i < 62 * 64 && !p_nofill) *(LAS v4u*)(UH + (i >> 6) * 1024 + (i & 63) * 16) = tmp[k]; }
                __syncthreads();
                if (!p_nocomp) att::mix_rows<4, false>(UH, WDW, wave * 4, (size_t)r0 + wave * 4, bdw, gcn, bcn, OMLA, MIX, lane);
            } else { const int bs = it - 512;
                f32x4 ta[4], tc[4]; v4u tu[2];
#pragma unroll
                for (int k = 0; k < 4; ++k) { const int i = tid + 512 * k, lr = (i >> 6) < CST - 1 ? (i >> 6) : CST - 1, ch = i & 63; const float* sp = st_conv + ((size_t)bs * CST + lr) * CC + ch * 8;
                    ta[k] = *(const f32x4*)sp; tc[k] = *(const f32x4*)(sp + 4); }
#pragma unroll
                for (int k = 0; k < 2; ++k) { const int i = tid + 512 * k; tu[k] = *(const v4u*)(U + ((size_t)TP + bs * SSEQ + (i >> 6)) * CC + (i & 63) * 8); }
#pragma unroll
                for (int k = 0; k < 4; ++k) { const int i = tid + 512 * k; v4u v; v.x = pk2(ta[k].x, ta[k].y); v.y = pk2(ta[k].z, ta[k].w); v.z = pk2(tc[k].x, tc[k].y); v.w = pk2(tc[k].z, tc[k].w);
                    if (i < CST * 64) *(LAS v4u*)(UH + (i >> 6) * 1024 + (i & 63) * 16) = v; }
#pragma unroll
                for (int k = 0; k < 2; ++k) { const int i = tid + 512 * k; *(LAS v4u*)(UH + (CST + (i >> 6)) * 1024 + (i & 63) * 16) = tu[k]; }
                __syncthreads();
                if (prun && ((MK_DUP >> 21) & 1)) att::mix_rows<2, false>(UH, WDW, wave * 2, (size_t)TP + bs * SSEQ + wave * 2, bdw, gcn, bcn, OMLA, MIX, lane);
                else att::mix_rows<2, true>(UH, WDW, wave * 2, (size_t)TP + bs * SSEQ + wave * 2, bdw, gcn, bcn, OMLA, MIX, lane, PART, ML);
            }
        }
        if (BOTH(5)) GRID_BAR();
    }
    if (IN(6)) {
        pg8::Gemm g{MIX, Wo_t, T, DM, DM}; pg8::PanelSplitOrder S; S.init(G, (int)blockIdx.x, DM, MT6);
        if ((MK_DUP >> 6) & 1) { pg8::PanelSplitOrder Sd; Sd.init(G, (int)blockIdx.x, DM, MT6, ((MK_DUP >> 15) & 1) == 0); pg8::EpiWo Ed{x_p, HB, (float*)(ws + WS_ML), (float*)(ws + WS_SLAB6), MT6, (MK_DUP >> 12) & 7};
            pg8::gemm_phase<pg8::EpiWo, pg8::PanelSplitOrder, true, true>(ldsp + RING_OFF, g, Sd, Ed); GRID_BAR(); }
        pg8::EpiWo E{x_p, HB, SSQ_H, (float*)(ws + WS_SLAB6), MT6, 0};
        pg8::gemm_phase<pg8::EpiWo, pg8::PanelSplitOrder, true, true>(ldsp + RING_OFF, g, S, E);
        if (BOTH(6)) GRID_BAR();
    }
    if (IN(7)) {
        PHASE_IDS();
        for (int r = gw; r < TS; r += NGW) { const GAS f32x4* xr = (const GAS f32x4*)(x_s + (size_t)r * DM) + lane; f32x4 v[4]; float s = 0.f;
#pragma unroll
            for (int j = 0; j < 4; ++j) v[j] = xr[64 * j];
            for (int sl = 0; sl < DM / 64 / MT6; ++sl) { const GAS f32x4* sr = (const GAS f32x4*)((const float*)(ws + WS_SLAB6) + ((size_t)sl * 256 + r) * DM) + lane;
#pragma unroll
                for (int j = 0; j < 4; ++j) v[j] += sr[64 * j]; }
            GAS unsigned long long* o8 = (GAS unsigned long long*)(HB + ((size_t)TP + r) * DM) + lane;
#pragma unroll
            for (int j = 0; j < 4; ++j) { s += (v[j].x * v[j].x + v[j].y * v[j].y) + (v[j].z * v[j].z + v[j].w * v[j].w); o8[64 * j] = (unsigned long long)pk2(v[j].x, v[j].y) | ((unsigned long long)pk2(v[j].z, v[j].w) << 32); }
            s = att::wave_sum(s); if (lane == 0) SSQ_H[TP + r] = s; }
        if (BOTH(7)) GRID_BAR();
    }
    if (IN(8)) {
        pg8::Gemm g{HB, Wgu_t, T, NGU, DM}; pg8::StaticOrder S; S.init(T, NGU, G, (int)blockIdx.x);
        if ((MK_DUP >> 8) & 1) { pg8::EpiGU Ed{ACT, SSQ_H, (MK_DUP >> 12) & 7};
            pg8::gemm_phase<pg8::EpiGU, pg8::StaticOrder, true, true>(ldsp + RING_OFF, g, S, Ed); GRID_BAR(); }
        pg8::EpiGU E{ACT, SSQ_H, 0};
        pg8::gemm_phase<pg8::EpiGU, pg8::StaticOrder, true, true>(ldsp + RING_OFF, g, S, E);
        if (BOTH(8)) GRID_BAR();
    }
    if (IN(9)) {
        pg8::Gemm g{ACT, Wd_t, T, DM, DFF}; pg8::PanelSplitOrder S; S.init(G, (int)blockIdx.x, DFF, MT8);
        if ((MK_DUP >> 9) & 1) { pg8::PanelSplitOrder Sd; Sd.init(G, (int)blockIdx.x, DFF, MT8, ((MK_DUP >> 15) & 1) == 0); pg8::EpiDown Ed{(bf16*)(ws + WS_H2), HB, (float*)(ws + WS_SLAB8), MT8};
            pg8::gemm_phase<pg8::EpiDown, pg8::PanelSplitOrder, true, true>(ldsp + RING_OFF, g, Sd, Ed); GRID_BAR(); }
        pg8::EpiDown E{(bf16*)(ws + WS_H2), HB, (float*)(ws + WS_SLAB8), MT8};
        pg8::gemm_phase<pg8::EpiDown, pg8::PanelSplitOrder, true, true>(ldsp + RING_OFF, g, S, E);
        if (BOTH(9)) GRID_BAR();
    }
    if (IN(10)) {
        PHASE_IDS();
        bf16* H2 = (bf16*)(ws + WS_H2);
        if ((MK_DUP >> 10) & 1) { for (int m = gw; m < T; m += NGW) rms_row(nullptr, g_final, nullptr, (float*)(ws + WS_XN) + (size_t)m * DM, lane, m >= TP ? (const float*)(ws + WS_SLAB8) + (size_t)(m - TP) * DM : nullptr, DFF / 64 / MT8, m >= TP ? HB + (size_t)m * DM : H2 + (size_t)m * DM); GRID_BAR(); }
        for (int m = gw; m < T; m += NGW) rms_row(nullptr, g_final, nullptr, Y + (size_t)m * DM, lane, m >= TP ? (const float*)(ws + WS_SLAB8) + (size_t)(m - TP) * DM : nullptr, DFF / 64 / MT8, m >= TP ? HB + (size_t)m * DM : H2 + (size_t)m * DM);
    }
#undef IN
#undef BOTH
}

extern "C" void kernel_launch(void* const* d_in, const int* in_sizes, int n_in, void* d_out, int out_size, void* d_ws, size_t ws_size, hipStream_t stream) {
    static int grid = 0;
    if (grid == 0) {
        if (n_in != 24 || in_sizes[0] != TP * DM || (size_t)out_size != O_END || ws_size < WS_END) { fprintf(stderr, "kernel_launch: shape mismatch (n_in %d, in0 %d, out %d, ws %zu); nothing launched\n", n_in, n_in > 0 ? in_sizes[0] : -1, out_size, ws_size); grid = -1; return; }
        int dev = 0, cus = 0, per_cu = 0;
        if (hipGetDevice(&dev) != hipSuccess || hipDeviceGetAttribute(&cus, hipDeviceAttributeMultiprocessorCount, dev) != hipSuccess) { fprintf(stderr, "kernel_launch: device query failed\n"); grid = -1; return; }
        if (hipFuncSetAttribute((const void*)mk_fwd, hipFuncAttributeMaxDynamicSharedMemorySize, LDS_BYTES) != hipSuccess) { fprintf(stderr, "kernel_launch: hipFuncSetAttribute failed\n"); grid = -1; return; }
        if (hipOccupancyMaxActiveBlocksPerMultiprocessor(&per_cu, (const void*)mk_fwd, NWAVES * 64, LDS_BYTES) != hipSuccess || per_cu < 1) { fprintf(stderr, "kernel_launch: occupancy query says %d workgroups per CU; nothing launched\n", per_cu); (void)hipGetLastError(); grid = -1; return; }
        grid = cus;
    }
    if (grid < 0) return;
    if (hipMemsetAsync((char*)d_ws + WS_CTL, 0, CTL_ZERO_BYTES, stream) != hipSuccess) { fprintf(stderr, "kernel_launch: hipMemsetAsync failed\n"); return; }
    Args a{};
    for (int i = 0; i < 24; ++i) a.in[i] = (const float*)d_in[i];
    a.out = (float*)d_out; a.ws = (unsigned char*)d_ws;
    for (int li = 0; li < N_LAUNCHES; ++li) {
        a.ph_lo = (N_LAUNCHES == NPHASE) ? li : 0; a.ph_hi = (N_LAUNCHES == NPHASE) ? li + 1 : NPHASE;
        hipLaunchKernelGGL(mk_fwd, dim3(grid), dim3(NWAVES * 64), LDS_BYTES, stream, a);
        const hipError_t le = hipPeekAtLastError();
        if (le != hipSuccess) { fprintf(stderr, "kernel_launch: launch %d failed: %s\n", li, hipGetErrorName(le)); break; }
    }
}
```

```cpp
#include <hip/hip_runtime.h>
#include <hip/hip_bf16.h>
#include <cstdio>
#include <cstdint>
#include <cmath>
#define LAS __attribute__((address_space(3)))
#define GAS __attribute__((address_space(1)))

constexpr int DM = 1024, NBATCH = 8, SEQ = 2048, SBATCH = 16, SSEQ = 16, PAST = 4096;
constexpr int TP = NBATCH * SEQ, TS = SBATCH * SSEQ, T = TP + TS;
constexpr int QL = 384, KVL = 256, RD = 32, CC = 512, INW = 1696, NH = 8, DFF = 2816, CW = 31, CST = 30;
constexpr int N1 = 1792, NQ = 768, NKV = 1024, NGU = 2 * DFF;
constexpr float EPS = 1e-6f;
constexpr float QSCALE = 0.10206207261596575f * 1.4426950408889634f;
constexpr int NPOS = SEQ + SSEQ;
constexpr size_t O_Y = 0, O_KVP = (size_t)T * DM, O_KRP = O_KVP + (size_t)TP * KVL, O_CVP = O_KRP + (size_t)TP * RD,
                 O_KVS = O_CVP + (size_t)NBATCH * CST * CC, O_KRS = O_KVS + (size_t)TS * KVL, O_CVS = O_KRS + (size_t)TS * RD, O_END = O_CVS + (size_t)SBATCH * CST * CC;
__device__ __forceinline__ int posidx(int row) { return row < TP ? (row & (SEQ - 1)) : SEQ + ((row - TP) & (SSEQ - 1)); }

namespace pg8 {
#define PG8_LAS __attribute__((address_space(3)))
typedef unsigned short bf16_t;
typedef short bf16x8 __attribute__((ext_vector_type(8)));
typedef float f32x4 __attribute__((ext_vector_type(4)));
typedef unsigned u32x4 __attribute__((ext_vector_type(4)));
constexpr int BM = 256, BK = 64, HALF = 128, HTB = HALF * BK * 2  , STAGE_BYTES = 8 * HTB, NXCD = 8, WGM = 8;

__host__ __device__ __forceinline__ int lds_byte(int r, int c) { const int st = (r >> 4) * 2 + (c >> 5), rr = r & 15, cc = c & 31, ob = rr * 64 + cc * 2; return st * 1024 + (ob ^ (((ob >> 9) & 1) << 5)); }
__host__ __device__ __forceinline__ void stage_rc(int b, int& R, int& C) { const int st = b / 1024, sb = b % 1024, swz = sb ^ (((sb >> 9) & 1) << 5); R = (st >> 1) * 16 + swz / 64; C = (st & 1) * 32 + (swz % 64) / 2; }
__host__ __device__ __forceinline__ int perm32(int rho) { const int n = rho >> 4, i = rho & 15; return 8 * (i >> 2) + 4 * n + (i & 3); }

struct Unit { int pm, pn, kt0, nt, kind; };
struct Gemm { const bf16_t* A; const bf16_t* Bt; int M, N, K; };

struct StaticOrder {
    int nM, nN, nwg, G, c;
    __host__ __device__ void init(int M, int N, int G_, int c_) { nM = M / BM; nN = N / BM; nwg = nM * nN; G = G_; c = c_; }
    __host__ __device__ bool next(int i, Unit& u) const {
        const long L = (long)i * G + c; if (L >= nwg) return false;
        int wgid = (int)L; { const int q = nwg / NXCD, r = nwg % NXCD, xcd = wgid % NXCD, off = wgid / NXCD; wgid = (xcd < r ? xcd * (q + 1) : r * (q + 1) + (xcd - r) * q) + off; }
        const int nig = WGM * nN, gid = wgid / nig, fm = gid * WGM, gsz = (nM - fm) < WGM ? (nM - fm) : WGM;
        u.pm = fm + ((wgid % nig) % gsz); u.pn = (wgid % nig) / gsz; u.kt0 = 0; u.nt = 0; u.kind = 0; return true;
    }
    __device__ __forceinline__ void a_ready(const Unit&) const {}
    __device__ __forceinline__ void done(const Unit&) const {}
};


__device__ __forceinline__ unsigned cvt_pk_bf16(float lo, float hi) { unsigned r; asm volatile("v_cvt_pk_bf16_f32 %0, %1, %2" : "=v"(r) : "v"(lo), "v"(hi)); return r; }
__device__ __forceinline__ u32x4 pack8(f32x4 a, f32x4 b) { u32x4 w; w.x = cvt_pk_bf16(a[0], a[1]); w.y = cvt_pk_bf16(a[2], a[3]); w.z = cvt_pk_bf16(b[0], b[1]); w.w = cvt_pk_bf16(b[2], b[3]); return w; }
__device__ __forceinline__ float sq4(f32x4 v) { return (v[0] * v[0] + v[1] * v[1]) + (v[2] * v[2] + v[3] * v[3]); }
__device__ __forceinline__ float sigm(float x) { return __builtin_amdgcn_rcpf(1.f + __builtin_amdgcn_exp2f(-1.4426950408889634f * x)); }
__device__ __forceinline__ f32x4 sigm4(f32x4 x) { return (f32x4){sigm(x[0]), sigm(x[1]), sigm(x[2]), sigm(x[3])}; }
__device__ __forceinline__ void rope4(const float* tab, f32x4& x1, f32x4& x2) {
    const f32x4 t0 = *(const f32x4*)tab, t1 = *(const f32x4*)(tab + 4);
    const f32x4 c = {t0[0], t0[2], t1[0], t1[2]}, s = {t0[1], t0[3], t1[1], t1[3]};
    const f32x4 y1 = x1 * c - x2 * s, y2 = x2 * c + x1 * s; x1 = y1; x2 = y2;
}

struct EpiBf16 {
    static constexpr bool PERM = true, AFTER_DRAIN = false, HAS_INIT = false;
    bf16_t* O; int ldc; int split_cols; size_t split_stride;
    __device__ __forceinline__ void operator()(const f32x4 (&acc)[2][2][4][2], const Unit& u, int wr, int wc, int fr, int fq) const {
        const int row0 = u.pm * BM + wr * 64 + fr; int colt = u.pn * BM; bf16_t* base = O;
        if (split_cols) { const int t = colt / split_cols; base += (size_t)t * split_stride; colt -= t * split_cols; }
        const int col0 = colt + wc * 32 + 8 * fq;
#pragma unroll
        for (int ai = 0; ai < 2; ++ai)
#pragma unroll
            for (int m = 0; m < 4; ++m) { bf16_t* rowp = base + (size_t)(row0 + ai * HALF + m * 16) * ldc + col0;
#pragma unroll
                for (int bj = 0; bj < 2; ++bj) *(u32x4*)(rowp + bj * HALF) = pack8(acc[ai][bj][m][0], acc[ai][bj][m][1]); }
    }
};

struct EpiProj {
    static constexpr bool PERM = true, AFTER_DRAIN = false, HAS_INIT = false;
    bf16_t *CKVN, *CQ, *KPE, *U; float* out; float* ssq_q; const float* g_kv; const float* rope; PG8_LAS float* ex;
    __device__ __forceinline__ void operator()(const f32x4 (&acc)[2][2][4][2], const Unit& u, int wr, int wc, int fr, int fq) const {
        const bool smp = (u.pm == TP / BM);
        const int rl0 = wr * 64 + fr;
        if (u.pn == 0) {
#pragma unroll
            for (int ai = 0; ai < 2; ++ai)
#pragma unroll
                for (int m = 0; m < 4; ++m) { float s = 0.f;
#pragma unroll
                    for (int bj = 0; bj < 2; ++bj) s += sq4(acc[ai][bj][m][0]) + sq4(acc[ai][bj][m][1]);
                    s += __shfl_xor(s, 16); s += __shfl_xor(s, 32);
                    if (fq == 0) ex[(ai * HALF + rl0 + m * 16) * 4 + wc] = s; }
            asm volatile("s_waitcnt lgkmcnt(0)" ::: "memory"); __builtin_amdgcn_s_barrier(); asm volatile("" ::: "memory");
            const int c0 = wc * 32 + 8 * fq;
            f32x4 g[2][2];
#pragma unroll
            for (int bj = 0; bj < 2; ++bj)
#pragma unroll
                for (int n = 0; n < 2; ++n) g[bj][n] = *(const f32x4*)(g_kv + c0 + bj * HALF + 4 * n);
            float* okv = smp ? out + O_KVS : out + O_KVP + (size_t)u.pm * BM * KVL;
#pragma unroll
            for (int ai = 0; ai < 2; ++ai)
#pragma unroll
                for (int m = 0; m < 4; ++m) { const int rl = ai * HALF + rl0 + m * 16; const f32x4 e = *(const PG8_LAS f32x4*)(ex + rl * 4);
                    const float r = rsqrtf(((e[0] + e[1]) + (e[2] + e[3])) * (1.0f / KVL) + EPS);
                    float* of = okv + (size_t)rl * KVL + c0; bf16_t* ob = CKVN + ((size_t)u.pm * BM + rl) * KVL + c0;
#pragma unroll
                    for (int bj = 0; bj < 2; ++bj) { const f32x4 v0 = acc[ai][bj][m][0] * r * g[bj][0], v1 = acc[ai][bj][m][1] * r * g[bj][1];
                        *(f32x4*)(of + bj * HALF) = v0; *(f32x4*)(of + bj * HALF + 4) = v1; *(u32x4*)(ob + bj * HALF) = pack8(v0, v1); } }
        } else if (u.pn <= 2) {
            const int nbj = (u.pn == 1) ? 2 : 1;
            const int cq0 = (u.pn - 1) * BM + wc * 32 + 8 * fq;
#pragma unroll
            for (int ai = 0; ai < 2; ++ai)
#pragma unroll
                for (int m = 0; m < 4; ++m) { const size_t row = (size_t)u.pm * BM + ai * HALF + rl0 + m * 16; float s = 0.f;
#pragma unroll
                    for (int bj = 0; bj < 2; ++bj) if (bj < nbj) { const f32x4 v0 = acc[ai][bj][m][0], v1 = acc[ai][bj][m][1]; s += sq4(v0) + sq4(v1);
                        *(u32x4*)(CQ + row * QL + cq0 + bj * HALF) = pack8(v0, v1); }
                    s += __shfl_xor(s, 16); s += __shfl_xor(s, 32);
                    if (fq == 0) atomicAdd(ssq_q + row, s);
                    if (u.pn == 2 && wc == 0) { f32x4 x1 = acc[ai][1][m][0], x2 = acc[ai][1][m][1];
                        rope4(rope + ((size_t)posidx((int)row) * 16 + 4 * fq) * 2, x1, x2);
                        float* okr = smp ? out + O_KRS + (row - TP) * RD : out + O_KRP + row * RD;
                        *(f32x4*)(okr + 4 * fq) = x1; *(f32x4*)(okr + 16 + 4 * fq) = x2; *(u32x4*)(KPE + row * RD + 8 * fq) = pack8(x1, x2); } }
        } else {
            const int cu = (u.pn - 3) * HALF + wc * 32 + 8 * fq;
            const bool cvp = !smp && ((u.pm & 7) == 7);
#pragma unroll
            for (int ai = 0; ai < 2; ++ai)
#pragma unroll
                for (int m = 0; m < 4; ++m) { const int rl = ai * HALF + rl0 + m * 16; const size_t row = (size_t)u.pm * BM + rl;
                    const f32x4 u0 = acc[ai][0][m][0] * sigm4(acc[ai][1][m][0]), u1 = acc[ai][0][m][1] * sigm4(acc[ai][1][m][1]);
                    *(u32x4*)(U + row * CC + cu) = pack8(u0, u1);
                    if (smp) { const int r = rl, b = r >> 4, s = r & 15; float* o = out + O_CVS + ((size_t)b * CST + (CST - SSEQ) + s) * CC + cu; *(f32x4*)o = u0; *(f32x4*)(o + 4) = u1; }
                    else if (cvp && rl >= BM - CST) { float* o = out + O_CVP + ((size_t)(u.pm >> 3) * CST + (rl - (BM - CST))) * CC + cu; *(f32x4*)o = u0; *(f32x4*)(o + 4) = u1; } }
        }
    }
};

struct EpiQ {
    static constexpr bool PERM = true, AFTER_DRAIN = false, HAS_INIT = false;
    bf16_t* Q; const float* ssq_q; const float* rope;
    __device__ __forceinline__ void operator()(const f32x4 (&acc)[2][2][4][2], const Unit& u, int wr, int wc, int fr, int fq) const {
        float rr[2][4];
#pragma unroll
        for (int ai = 0; ai < 2; ++ai)
#pragma unroll
            for (int m = 0; m < 4; ++m) rr[ai][m] = ssq_q[(size_t)u.pm * BM + ai * HALF + wr * 64 + m * 16 + fr];
#pragma unroll
        for (int ai = 0; ai < 2; ++ai)
#pragma unroll
            for (int m = 0; m < 4; ++m) { const size_t row = (size_t)u.pm * BM + ai * HALF + wr * 64 + m * 16 + fr;
                const float rq = rsqrtf(rr[ai][m] * (1.0f / QL) + EPS) * QSCALE; const float* tab = rope + (size_t)posidx((int)row) * 32;
#pragma unroll
                for (int bj = 0; bj < 2; ++bj) { const int c0 = u.pn * BM + bj * HALF + wc * 32 + 8 * fq; const int gi = (c0 >> 3) % 12;
                    f32x4 v0 = acc[ai][bj][m][0] * rq, v1 = acc[ai][bj][m][1] * rq;
                    const int g = gi >= 8 ? gi - 8 : 0; f32x4 y1 = v0, y2 = v1; rope4(tab + g * 8, y1, y2);
                    if (gi >= 8) { v0 = y1; v1 = y2; }
                    *(u32x4*)(Q + row * NQ + c0) = pack8(v0, v1); }
                asm volatile("" ::: "memory"); }
    }
};

struct PanelSplitOrder {
    StaticOrder so; int nmini, mt;
    __device__ __forceinline__ void init(int G_, int c_, int K, int mt_, bool minis = true) { so.init(TP, DM, G_, c_); mt = mt_; nmini = minis ? 4 * (K / BK / mt_) : 0; }
    __device__ __forceinline__ bool next(int i, Unit& u) const {
        const long L = (long)i * so.G + so.c;
        if (L < so.nwg) return so.next(i, u);
        const int m = (int)(L - so.nwg); if (m >= nmini) return false;
        u.pm = TP / BM; u.pn = m & 3; u.kt0 = (m >> 2) * mt; u.nt = mt; u.kind = 1; return true;
    }
    __device__ __forceinline__ void a_ready(const Unit&) const {}
    __device__ __forceinline__ void done(const Unit&) const {}
};

struct EpiWo {
    static constexpr bool PERM = true, AFTER_DRAIN = false, HAS_INIT = true;
    const float* xp; bf16_t* HB; float* ssq_h; float* SLAB; int mt; int probe;
    __device__ __forceinline__ void init(f32x4 (&acc)[2][2][4][2], const Unit& u, int wr, int wc, int fr, int fq) const {
        const int cb = u.pn * BM + wc * 32 + 8 * fq;
        if (u.kind == 0) {
#pragma unroll
            for (int ai = 0; ai < 2; ++ai)
#pragma unroll
                for (int m = 0; m < 4; ++m) { const float* xr = xp + ((size_t)u.pm * BM + ai * HALF + wr * 64 + m * 16 + fr) * DM + cb;
#pragma unroll
                    for (int bj = 0; bj < 2; ++bj)
#pragma unroll
                        for (int n = 0; n < 2; ++n) acc[ai][bj][m][n] = *(const f32x4*)(xr + bj * HALF + 4 * n); }
        } else {
#pragma unroll
            for (int ai = 0; ai < 2; ++ai)
#pragma unroll
                for (int m = 0; m < 4; ++m)
#pragma unroll
                    for (int bj = 0; bj < 2; ++bj)
#pragma unroll
                        for (int n = 0; n < 2; ++n) acc[ai][bj][m][n] = (f32x4){0.f, 0.f, 0.f, 0.f};
        }
    }
    __device__ __forceinline__ void operator()(const f32x4 (&acc)[2][2][4][2], const Unit& u, int wr, int wc, int fr, int fq) const {
        const int cb = u.pn * BM + wc * 32 + 8 * fq;
        if (probe == 2) {
#pragma unroll
            for (int ai = 0; ai < 2; ++ai)
#pragma unroll
                for (int bj = 0; bj < 2; ++bj)
#pragma unroll
                    for (int m = 0; m < 4; ++m) asm volatile("" :: "v"(acc[ai][bj][m][0]), "v"(acc[ai][bj][m][1]));
            return; }
        if (u.kind == 0) {
#pragma unroll
            for (int ai = 0; ai < 2; ++ai)
#pragma unroll
                for (int m = 0; m < 4; ++m) { const size_t row = (size_t)u.pm * BM + ai * HALF + wr * 64 + m * 16 + fr; float s = 0.f;
#pragma unroll
                    for (int bj = 0; bj < 2; ++bj) { *(u32x4*)(HB + row * DM + cb + bj * HALF) = pack8(acc[ai][bj][m][0], acc[ai][bj][m][1]); s += sq4(acc[ai][bj][m][0]) + sq4(acc[ai][bj][m][1]); }
                    s += __shfl_xor(s, 16); s += __shfl_xor(s, 32);
                    if (fq == 0) atomicAdd(ssq_h + row, s); }
        } else { const int sl = u.kt0 / mt;
#pragma unroll
            for (int ai = 0; ai < 2; ++ai)
#pragma unroll
                for (int m = 0; m < 4; ++m) { const int rl = ai * HALF + wr * 64 + m * 16 + fr;
#pragma unroll
                    for (int bj = 0; bj < 2; ++bj) { float* sp = SLAB + ((size_t)sl * BM + rl) * DM + cb + bj * HALF; *(f32x4*)sp = acc[ai][bj][m][0]; *(f32x4*)(sp + 4) = acc[ai][bj][m][1]; } }
        }
    }
};

struct EpiGU {
    static constexpr bool PERM = true, AFTER_DRAIN = false, HAS_INIT = false;
    bf16_t* ACT; const float* ssq_h; int probe;
    __device__ __forceinline__ void operator()(const f32x4 (&acc)[2][2][4][2], const Unit& u, int wr, int wc, int fr, int fq) const {
        if (probe == 2) {
#pragma unroll
            for (int ai = 0; ai < 2; ++ai)
#pragma unroll
                for (int bj = 0; bj < 2; ++bj)
#pragma unroll
                    for (int m = 0; m < 4; ++m) asm volatile("" :: "v"(acc[ai][bj][m][0]), "v"(acc[ai][bj][m][1]));
            return; }
        const int c0 = u.pn * HALF + wc * 32 + 8 * fq;
        const __amdgpu_buffer_rsrc_t rsrc = __builtin_amdgcn_make_buffer_rsrc(ACT, 0, 0x7fffffff, 0x00020000);
        float rr[2][4];
#pragma unroll
        for (int ai = 0; ai < 2; ++ai)
#pragma unroll
            for (int m = 0; m < 4; ++m) rr[ai][m] = ssq_h[(size_t)u.pm * BM + ai * HALF + wr * 64 + m * 16 + fr];
#pragma unroll
        for (int ai = 0; ai < 2; ++ai)
#pragma unroll
            for (int m = 0; m < 4; ++m) { const size_t row = (size_t)u.pm * BM + ai * HALF + wr * 64 + m * 16 + fr;
                const float r = rsqrtf(rr[ai][m] * (1.0f / DM) + EPS);
                const f32x4 g0 = acc[ai][0][m][0] * r, g1 = acc[ai][0][m][1] * r, u0 = acc[ai][1][m][0] * r, u1 = acc[ai][1][m][1] * r;
                const u32x4 w = pack8(g0 * sigm4(g0) * u0, g1 * sigm4(g1) * u1);
                if (probe != 3) __builtin_amdgcn_raw_buffer_store_b128(w, rsrc, (unsigned)((row * DFF + c0) * 2), 0, 16);
                else asm volatile("" :: "v"(w)); }
    }
};

struct EpiDown {
    static constexpr bool PERM = true, AFTER_DRAIN = false, HAS_INIT = true;
    bf16_t* H2; const bf16_t* HB; float* SLAB; int mt;
    __device__ __forceinline__ void init(f32x4 (&acc)[2][2][4][2], const Unit& u, int wr, int wc, int fr, int fq) const {
        const int cb = u.pn * BM + wc * 32 + 8 * fq;
        if (u.kind == 0) {
#pragma unroll
            for (int ai = 0; ai < 2; ++ai)
#pragma unroll
                for (int m = 0; m < 4; ++m) { const bf16_t* p = HB + ((size_t)u.pm * BM + ai * HALF + wr * 64 + m * 16 + fr) * DM + cb;
#pragma unroll
                    for (int bj = 0; bj < 2; ++bj) { const u32x4 h = *(const u32x4*)(p + bj * HALF);
                        acc[ai][bj][m][0] = (f32x4){__uint_as_float(h.x << 16), __uint_as_float(h.x & 0xffff0000u), __uint_as_float(h.y << 16), __uint_as_float(h.y & 0xffff0000u)};
                        acc[ai][bj][m][1] = (f32x4){__uint_as_float(h.z << 16), __uint_as_float(h.z & 0xffff0000u), __uint_as_float(h.w << 16), __uint_as_float(h.w & 0xffff0000u)}; } }
        } else {
#pragma unroll
            for (int ai = 0; ai < 2; ++ai)
#pragma unroll
                for (int m = 0; m < 4; ++m)
#pragma unroll
                    for (int bj = 0; bj < 2; ++bj)
#pragma unroll
                        for (int n = 0; n < 2; ++n) acc[ai][bj][m][n] = (f32x4){0.f, 0.f, 0.f, 0.f};
        }
    }
    __device__ __forceinline__ void operator()(const f32x4 (&acc)[2][2][4][2], const Unit& u, int wr, int wc, int fr, int fq) const {
        const int sl = u.kt0 / mt; const int cb = u.pn * BM + wc * 32 + 8 * fq;
        if (u.kind == 0) {
#pragma unroll
            for (int ai = 0; ai < 2; ++ai)
#pragma unroll
                for (int m = 0; m < 4; ++m) { bf16_t* p = H2 + ((size_t)u.pm * BM + ai * HALF + wr * 64 + m * 16 + fr) * DM + cb;
#pragma unroll
                    for (int bj = 0; bj < 2; ++bj) *(u32x4*)(p + bj * HALF) = pack8(acc[ai][bj][m][0], acc[ai][bj][m][1]); }
        } else {
#pragma unroll
            for (int ai = 0; ai < 2; ++ai)
#pragma unroll
                for (int m = 0; m < 4; ++m) { const int rl = ai * HALF + wr * 64 + m * 16 + fr;
#pragma unroll
                    for (int bj = 0; bj < 2; ++bj) { float* p = SLAB + ((size_t)sl * BM + rl) * DM + cb + bj * HALF; *(f32x4*)p = acc[ai][bj][m][0]; *(f32x4*)(p + 4) = acc[ai][bj][m][1]; } }
        }
    }
};

template <class Epi, class Sched, bool ALIGN_EPI = false, bool SP2 = false>
__device__ __forceinline__ void gemm_phase(PG8_LAS unsigned char* lds, const Gemm g, const Sched& S, const Epi& E, const f32x4 (&pre)[2][2][4][2], const bool use_pre) {
    int tid_ = threadIdx.x; asm volatile("" : "+v"(tid_));
    const int tid = tid_, wid = __builtin_amdgcn_readfirstlane(tid >> 6), lane = tid & 63, wr = wid >> 2, wc = wid & 3, fr = lane & 15, fq = lane >> 4;
    int K_ = g.K; asm volatile("" : "+s"(K_));
    const int K = K_, nt = K / BK;
    unsigned voffA[2], voffB[2];
#pragma unroll
    for (int i = 0; i < 2; ++i) { int R, C; stage_rc(tid * 16 + i * 8192, R, C); const int Rb = Epi::PERM ? ((R & ~31) + perm32(R & 31)) : R;
        voffA[i] = (unsigned)(R * K + C) * 2u; voffB[i] = (unsigned)(Rb * K + C) * 2u; }
    const size_t kstep = (size_t)(BK * 2);
    const size_t hstep = (size_t)HALF * K * 2;
    const size_t tstep = 2 * hstep;
    const unsigned ldsw = (unsigned)wid * 1024u;
    const int aoff = lds_byte(wr * 64 + fr, fq * 8), boff = lds_byte(wc * 32 + fr, fq * 8);
#define PG8_SA(b, h) (((b) * 2 + (h)) * HTB)
#define PG8_SB(b, h) ((4 + (b) * 2 + (h)) * HTB)
#define PG8_STAGE(bufoff, gbase, voff) do { _Pragma("unroll") for (int _i = 0; _i < 2; ++_i) \
        __builtin_amdgcn_global_load_lds((const unsigned*)((const char*)(gbase) + (voff)[_i]), (PG8_LAS unsigned*)(lds + (bufoff) + ldsw + _i * 8192), 16, 0, 0); } while (0)
#define PG8_LDA(dst, b, h) do { _Pragma("unroll") for (int m = 0; m < 4; ++m) _Pragma("unroll") for (int k = 0; k < 2; ++k) dst[m][k] = *(const PG8_LAS bf16x8*)(lds + PG8_SA(b, h) + aoff + m * 2048 + k * 1024); } while (0)
#define PG8_LDB(dst, b, h) do { _Pragma("unroll") for (int n = 0; n < 2; ++n) _Pragma("unroll") for (int k = 0; k < 2; ++k) dst[n][k] = *(const PG8_LAS bf16x8*)(lds + PG8_SB(b, h) + boff + n * 2048 + k * 1024); } while (0)
#define PG8_MMA(ai, bj, At, Bt) do { __builtin_amdgcn_s_setprio(1); _Pragma("unroll") for (int m = 0; m < 4; ++m) _Pragma("unroll") for (int n = 0; n < 2; ++n) _Pragma("unroll") for (int k = 0; k < 2; ++k) \
        acc[ai][bj][m][n] = __builtin_amdgcn_mfma_f32_16x16x32_bf16(Bt[n][k], At[m][k], acc[ai][bj][m][n], 0, 0, 0); __builtin_amdgcn_s_setprio(0); } while (0)
#define PG8_WAIT_V(n) asm volatile("s_waitcnt vmcnt(" #n ")" ::: "memory")
#define PG8_WAIT_L(n) asm volatile("s_waitcnt lgkmcnt(" #n ")" ::: "memory")
#define PG8_BAR __builtin_amdgcn_s_barrier()
#define PG8_SCHED __builtin_amdgcn_sched_barrier(0)
    Unit cur, nxt; int ui = 0;
    if (!S.next(0, cur)) return;
    f32x4 acc[2][2][4][2];
#define PG8_ACC_INIT(u) do { if constexpr (Epi::HAS_INIT) { int t3 = tid; asm volatile("" : "+v"(t3)); E.init(acc, (u), wr, wc, t3 & 15, (t3 >> 4) & 3); } else { \
        _Pragma("unroll") for (int a = 0; a < 2; ++a) _Pragma("unroll") for (int b = 0; b < 2; ++b) _Pragma("unroll") for (int m = 0; m < 4; ++m) _Pragma("unroll") for (int n = 0; n < 2; ++n) acc[a][b][m][n] = (f32x4){0.f, 0.f, 0.f, 0.f}; } } while (0)
    if (use_pre) {
#pragma unroll
        for (int a = 0; a < 2; ++a)
#pragma unroll
            for (int b2 = 0; b2 < 2; ++b2)
#pragma unroll
                for (int m = 0; m < 4; ++m)
#pragma unroll
                    for (int n = 0; n < 2; ++n) acc[a][b2][m][n] = pre[a][b2][m][n];
    } else PG8_ACC_INIT(cur);
    bf16x8 At[4][2], B0[2][2], B1[2][2];
#define PG8_UA(u) ((const char*)g.A + (size_t)(u).pm * tstep + (size_t)(u).kt0 * kstep)
#define PG8_UB(u) ((const char*)g.Bt + (size_t)(u).pn * tstep + (size_t)(u).kt0 * kstep)
    const char* cA = PG8_UA(cur); const char* cB = PG8_UB(cur);
    S.a_ready(cur);
    if constexpr (SP2) {
        PG8_STAGE(PG8_SB(0, 0), cB, voffB); PG8_STAGE(PG8_SB(0, 1), cB + hstep, voffB); PG8_STAGE(PG8_SA(0, 0), cA, voffA); PG8_STAGE(PG8_SA(0, 1), cA + hstep, voffA);
        if (wr == 1) PG8_BAR;
        PG8_WAIT_V(2); PG8_BAR;
        PG8_STAGE(PG8_SB(1, 0), cB + kstep, voffB); PG8_STAGE(PG8_SA(1, 0), cA + kstep, voffA); PG8_STAGE(PG8_SB(1, 1), cB + hstep + kstep, voffB);
        PG8_WAIT_V(6); PG8_BAR;
    } else {
        PG8_STAGE(PG8_SB(0, 0), cB, voffB); PG8_STAGE(PG8_SA(0, 0), cA, voffA); PG8_STAGE(PG8_SB(0, 1), cB + hstep, voffB); PG8_STAGE(PG8_SA(0, 1), cA + hstep, voffA);
        if (wr == 1) PG8_BAR;
        PG8_WAIT_V(4); PG8_BAR;
        PG8_STAGE(PG8_SB(1, 0), cB + kstep, voffB); PG8_STAGE(PG8_SA(1, 0), cA + kstep, voffA); PG8_STAGE(PG8_SB(1, 1), cB + hstep + kstep, voffB);
        PG8_WAIT_V(6); PG8_BAR;
    }
    for (;;) {
        const bool has_next = S.next(ui + 1, nxt);
        const char* nA = has_next ? PG8_UA(nxt) : cA; const char* nB = has_next ? PG8_UB(nxt) : cB;
        const int unt = cur.nt ? cur.nt : nt;
        for (int t = 0; t < unt; t += 2) {
            const bool last = (t == unt - 2);
            const char* a1 = cA + (size_t)(t + 1) * kstep;
            const char* a2 = last ? nA : cA + (size_t)(t + 2) * kstep; const char* b2 = last ? nB : cB + (size_t)(t + 2) * kstep;
            const char* a3 = a2 + kstep; const char* b3 = b2 + kstep;
            if (last && has_next) S.a_ready(nxt);
            if constexpr (SP2) {
            PG8_LDB(B0, 0, 0); PG8_LDB(B1, 0, 1); PG8_SCHED; PG8_LDA(At, 0, 0); PG8_STAGE(PG8_SA(1, 1), a1 + hstep, voffA);
            PG8_WAIT_V(8); PG8_WAIT_L(0); PG8_BAR; PG8_MMA(0, 0, At, B0); PG8_MMA(0, 1, At, B1); PG8_BAR; PG8_SCHED;
            PG8_LDA(At, 0, 1); PG8_STAGE(PG8_SB(0, 0), b2, voffB); PG8_STAGE(PG8_SB(0, 1), b2 + hstep, voffB); PG8_STAGE(PG8_SA(0, 0), a2, voffA);
            PG8_WAIT_V(8); PG8_WAIT_L(0); PG8_BAR; PG8_MMA(1, 0, At, B0); PG8_MMA(1, 1, At, B1); PG8_BAR; PG8_SCHED;
            PG8_LDB(B0, 1, 0); PG8_LDB(B1, 1, 1); PG8_SCHED; PG8_LDA(At, 1, 0); PG8_STAGE(PG8_SA(0, 1), a2 + hstep, voffA);
            PG8_WAIT_V(8); PG8_WAIT_L(0); PG8_BAR; PG8_MMA(0, 0, At, B0); PG8_MMA(0, 1, At, B1); PG8_BAR; PG8_SCHED;
            PG8_LDA(At, 1, 1); PG8_STAGE(PG8_SB(1, 0), b3, voffB); PG8_STAGE(PG8_SB(1, 1), b3 + hstep, voffB); PG8_STAGE(PG8_SA(1, 0), a3, voffA);
            PG8_WAIT_V(8); PG8_WAIT_L(0); PG8_BAR; PG8_MMA(1, 0, At, B0); PG8_MMA(1, 1, At, B1); PG8_BAR; PG8_SCHED;
            } else {
            PG8_LDB(B0, 0, 0); PG8_SCHED; PG8_LDA(At, 0, 0); PG8_STAGE(PG8_SA(1, 1), a1 + hstep, voffA);
            PG8_WAIT_L(8); PG8_BAR; PG8_WAIT_L(0); PG8_MMA(0, 0, At, B0); PG8_BAR; PG8_SCHED;
            PG8_LDB(B1, 0, 1); PG8_STAGE(PG8_SB(0, 0), b2, voffB);
            PG8_BAR; PG8_WAIT_L(0); PG8_MMA(0, 1, At, B1); PG8_BAR;
            PG8_LDA(At, 0, 1); PG8_STAGE(PG8_SA(0, 0), a2, voffA);
            PG8_BAR; PG8_WAIT_L(0); PG8_MMA(1, 0, At, B0); PG8_BAR; PG8_SCHED;
            PG8_STAGE(PG8_SB(0, 1), b2 + hstep, voffB);
            PG8_WAIT_V(6); PG8_BAR; PG8_MMA(1, 1, At, B1); PG8_BAR;
            PG8_LDB(B0, 1, 0); PG8_SCHED; PG8_LDA(At, 1, 0); PG8_STAGE(PG8_SA(0, 1), a2 + hstep, voffA);
            PG8_WAIT_L(8); PG8_BAR; PG8_WAIT_L(0); PG8_MMA(0, 0, At, B0); PG8_BAR; PG8_SCHED;
            PG8_LDB(B1, 1, 1); PG8_STAGE(PG8_SB(1, 0), b3, voffB);
            PG8_BAR; PG8_WAIT_L(0); PG8_MMA(0, 1, At, B1); PG8_BAR;
            PG8_LDA(At, 1, 1); PG8_STAGE(PG8_SA(1, 0), a3, voffA);
            PG8_BAR; PG8_WAIT_L(0); PG8_MMA(1, 0, At, B0); PG8_BAR; PG8_SCHED;
            PG8_STAGE(PG8_SB(1, 1), b3 + hstep, voffB);
            PG8_WAIT_V(6); PG8_BAR; PG8_MMA(1, 1, At, B1); PG8_BAR;
            }
        }
        if constexpr (ALIGN_EPI) { if (wr == 0) PG8_BAR; }
        if constexpr (!Epi::AFTER_DRAIN) { int t2 = tid; asm volatile("" : "+v"(t2)); const int fr2 = t2 & 15, fq2 = (t2 >> 4) & 3;
            E(acc, cur, wr, wc, fr2, fq2); S.done(cur); }
        if (!has_next) break;
        PG8_ACC_INIT(nxt);
        cur = nxt; cA = nA; cB = nB; ++ui;
        if constexpr (ALIGN_EPI) { if (wr == 1) PG8_BAR; }
    }
    PG8_WAIT_V(0);
    if constexpr (!ALIGN_EPI) { if (wr == 0) PG8_BAR; }
    PG8_BAR;
    if constexpr (Epi::AFTER_DRAIN) { E.fused(acc, cur, wr, wc, fr, fq, lds, wid, lane); S.done(cur); }
#undef PG8_ACC_INIT
#undef PG8_UA
#undef PG8_UB
#undef PG8_SA
#undef PG8_SB
#undef PG8_STAGE
#undef PG8_LDA
#undef PG8_LDB
#undef PG8_MMA
#undef PG8_WAIT_V
#undef PG8_WAIT_L
#undef PG8_BAR
#undef PG8_SCHED
}
}
namespace att {
using bf16x8 = __attribute__((ext_vector_type(8))) short;
using s16x4 = __attribute__((ext_vector_type(4))) short;
using f32x16 = __attribute__((ext_vector_type(16))) float;
using f32x4 = __attribute__((ext_vector_type(4))) float;
using u32x4 = __attribute__((ext_vector_type(4))) unsigned;
using u32x2 = __attribute__((ext_vector_type(2))) unsigned;
typedef unsigned short bf16;
typedef LAS char* lptr;
typedef short v4i16_t __attribute__((ext_vector_type(4)));
#define SBAR() __builtin_amdgcn_sched_barrier(0)
__device__ __forceinline__ int crow(int r, int hi) { return (r & 3) + 8 * (r >> 2) + 4 * hi; }
__device__ __forceinline__ void glds16(const void* gsrc, unsigned lds_dst) { unsigned keep;
    asm volatile("s_mov_b32 %0, m0\n\ts_mov_b32 m0, %2\n\ts_nop 0\n\tglobal_load_lds_dwordx4 %1, off\n\ts_mov_b32 m0, %0" : "=&s"(keep) : "v"(gsrc), "s"(lds_dst) : "memory"); }
__device__ __forceinline__ float max3f(float a, float b, float c) { float r; asm("v_max3_f32 %0, %1, %2, %3" : "=v"(r) : "v"(a), "v"(b), "v"(c)); return r; }
__device__ __forceinline__ float max2f(float a, float b) { float r; asm("v_max_f32_e32 %0, %1, %2" : "=v"(r) : "v"(a), "v"(b)); return r; }
typedef float f32x2_t __attribute__((ext_vector_type(2))); typedef __bf16 bf16x2_t __attribute__((ext_vector_type(2)));
__device__ __forceinline__ unsigned cvtpk_s(float lo, float hi) { f32x2_t v = {lo, hi}; bf16x2_t b = __builtin_convertvector(v, bf16x2_t); return __builtin_bit_cast(unsigned, b); }
__device__ __forceinline__ unsigned short f2bf(float f) { unsigned u = __builtin_bit_cast(unsigned, f); return (unsigned short)((u + 0x7fffu + ((u >> 16) & 1u)) >> 16); }
__device__ __forceinline__ float wave_sum(float v) {
    v += __builtin_bit_cast(float, __builtin_amdgcn_update_dpp(0, __builtin_bit_cast(int, v), 0xB1, 0xF, 0xF, true));
    v += __builtin_bit_cast(float, __builtin_amdgcn_update_dpp(0, __builtin_bit_cast(int, v), 0x4E, 0xF, 0xF, true));
    v += __builtin_bit_cast(float, __builtin_amdgcn_update_dpp(0, __builtin_bit_cast(int, v), 0x141, 0xF, 0xF, true));
    v += __builtin_bit_cast(float, __builtin_amdgcn_update_dpp(0, __builtin_bit_cast(int, v), 0x140, 0xF, 0xF, true));
    { auto r = __builtin_amdgcn_permlane16_swap(__float_as_uint(v), __float_as_uint(v), false, false); v = __uint_as_float(r[0]) + __uint_as_float(r[1]); }
    { auto r = __builtin_amdgcn_permlane32_swap(__float_as_uint(v), __float_as_uint(v), false, false); v = __uint_as_float(r[0]) + __uint_as_float(r[1]); }
    return v;
}
#define WAIT_ALL_BAR() asm volatile("s_waitcnt vmcnt(0) lgkmcnt(0)\n\ts_barrier" ::: "memory")

constexpr int KSLOT = 12288, VSLOT = 8192, NKS = 2, NVS = 3;
constexpr int L_K = 0, L_V = NKS * KSLOT, L_WS = L_V + NVS * VSLOT, L_OST = L_WS + 8 * 256, L_END = L_OST + 8 * 4096;

__device__ __forceinline__ void qkt6(f32x16& p0, f32x16& p1, const char* Kslot, const bf16x8* qr, int r32, int hi) {
    const char* kb = Kslot + hi * 1024 + r32 * 16;
    const f32x16 z = f32x16{};
#pragma unroll
    for (int d0 = 0; d0 < 6; ++d0) {
        const bf16x8 b0 = *reinterpret_cast<const bf16x8*>(kb + d0 * 2048);
        const bf16x8 b1 = *reinterpret_cast<const bf16x8*>(kb + d0 * 2048 + 512);
        if (d0 == 0) { p0 = __builtin_amdgcn_mfma_f32_32x32x16_bf16(b0, qr[0], z, 0, 0, 0); p1 = __builtin_amdgcn_mfma_f32_32x32x16_bf16(b1, qr[0], z, 0, 0, 0); }
        else { p0 = __builtin_amdgcn_mfma_f32_32x32x16_bf16(b0, qr[d0], p0, 0, 0, 0); p1 = __builtin_amdgcn_mfma_f32_32x32x16_bf16(b1, qr[d0], p1, 0, 0, 0); } }
}
__device__ __forceinline__ float rowmax(const f32x16& p0, const f32x16& p1) {
    float a = max3f(p0[0], p0[1], p1[0]), b = max3f(p0[2], p0[3], p1[1]); a = max3f(a, p1[2], p1[3]);
#pragma unroll
    for (int r = 4; r < 16; r += 4) { a = max3f(a, p0[r], p0[r + 1]); b = max3f(b, p0[r + 2], p0[r + 3]); a = max3f(a, p1[r], p1[r + 1]); b = max3f(b, p1[r + 2], p1[r + 3]); }
    const float m = max2f(a, b);
    auto rr = __builtin_amdgcn_permlane32_swap(__float_as_uint(m), __float_as_uint(m), false, false);
    return max2f(__uint_as_float(rr[0]), __uint_as_float(rr[1]));
}
__device__ __forceinline__ void pv(f32x16* o, int vb, bf16x8 pa0, bf16x8 pa1, bf16x8 pa2, bf16x8 pa3) {
#pragma unroll
    for (int d0 = 0; d0 < 2; ++d0) { s16x4 lo[4], hi[4];
#pragma unroll
        for (int ks = 0; ks < 4; ++ks) {
            asm volatile("ds_read_b64_tr_b16 %0,%1 offset:%c2" : "=&v"(lo[ks]) : "v"(vb), "i"(d0 * 4096 + ks * 1024) : "memory");
            asm volatile("ds_read_b64_tr_b16 %0,%1 offset:%c2" : "=&v"(hi[ks]) : "v"(vb), "i"(d0 * 4096 + ks * 1024 + 512) : "memory"); }
        asm volatile("s_waitcnt lgkmcnt(0)" ::: "memory"); SBAR();
#define PK(k) (bf16x8){lo[k][0], lo[k][1], lo[k][2], lo[k][3], hi[k][0], hi[k][1], hi[k][2], hi[k][3]}
        o[d0] = __builtin_amdgcn_mfma_f32_32x32x16_bf16(pa0, PK(0), o[d0], 0, 0, 0);
        o[d0] = __builtin_amdgcn_mfma_f32_32x32x16_bf16(pa1, PK(1), o[d0], 0, 0, 0);
        o[d0] = __builtin_amdgcn_mfma_f32_32x32x16_bf16(pa2, PK(2), o[d0], 0, 0, 0);
        o[d0] = __builtin_amdgcn_mfma_f32_32x32x16_bf16(pa3, PK(3), o[d0], 0, 0, 0);
#undef PK
    }
}

__device__ __forceinline__ void prompt_unit(int b, int h, int qb, const bf16* Q, const bf16* __restrict__ KN, const bf16* __restrict__ KPE, const bf16* __restrict__ V, bf16* O, char* shm) {
    int tid_ = threadIdx.x; asm volatile("" : "+v"(tid_)); const int tid = tid_, lane = tid & 63, r32 = lane & 31, hi = lane >> 5; const int wid = __builtin_amdgcn_readfirstlane(tid >> 6);
    const long rowbase = (long)b * SEQ; const int q0 = qb * 256;
    const bf16* Qw = Q + (rowbase + q0 + wid * 32) * NQ + h * 96;
    const unsigned lds0 = (unsigned)(uintptr_t)shm;
    float* wsf = (float*)(shm + L_WS) + wid * 64;
    const bf16* ksrc = KN + (rowbase + lane) * 512 + h * 64 + wid * 8;
    const bf16* psrc = KPE + (rowbase + lane) * RD + (wid & 3) * 8;
    const bf16* vsrc = V + (rowbase + 16 * (wid & 3) + (lane >> 2)) * 512 + h * 64 + (wid >> 2) * 32 + (lane & 3) * 8;
    const unsigned kdst = lds0 + L_K + wid * 1024, pdst = lds0 + L_K + (8 + (wid & 3)) * 1024, vdst = lds0 + L_V + wid * 1024;
#define DMA_KV(t, ks, vs) do { glds16(ksrc + (long)(t) * 64 * 512, (unsigned)__builtin_amdgcn_readfirstlane(kdst + (ks) * KSLOT)); \
        if (wid < 4) glds16(psrc + (long)(t) * 64 * RD, (unsigned)__builtin_amdgcn_readfirstlane(pdst + (ks) * KSLOT)); \
        glds16(vsrc + (long)(t) * 64 * 512, (unsigned)__builtin_amdgcn_readfirstlane(vdst + (vs) * VSLOT)); } while (0)
    const int vb0 = (int)(lds0 + L_V) + ((lane >> 4) & 1) * 32 + (lane & 3) * 8 + (4 * hi + ((lane & 15) >> 2)) * 64;
    const char* Kbase = shm + L_K;
    const int NT = 4 * qb + 4, nvis = 4 * qb + (wid >> 1) + 1;
    DMA_KV(0, 0, 0);
    bf16x8 qr[6];
#pragma unroll
    for (int d0 = 0; d0 < 6; ++d0) qr[d0] = *reinterpret_cast<const bf16x8*>(&Qw[(long)r32 * NQ + d0 * 16 + hi * 8]);
    float m = -1e30f, l = 0.f; f32x16 o[2]; o[0] = f32x16{}; o[1] = f32x16{};
    f32x16 p0, p1;
    WAIT_ALL_BAR();
#define SM_PV(vs) do { const float rm = rowmax(p0, p1); \
        const float mn = __builtin_fmaxf(m, rm); const float f = __builtin_amdgcn_exp2f(m - mn); m = mn; float sacc = 0.f; \
        _Pragma("unroll") for (int r = 0; r < 16; ++r) { p0[r] = __builtin_amdgcn_exp2f(p0[r] - mn); p1[r] = __builtin_amdgcn_exp2f(p1[r] - mn); sacc += p0[r] + p1[r]; } \
        l = l * f + sacc; \
        if (__any(f != 1.0f)) { if (hi == 0) wsf[r32] = f; asm volatile("s_waitcnt lgkmcnt(0)" ::: "memory"); \
            _Pragma("unroll") for (int r = 0; r < 16; ++r) { const float fr_ = wsf[crow(r, hi)]; o[0][r] *= fr_; o[1][r] *= fr_; } } \
        const u32x4 pw0 = {cvtpk_s(p0[0], p0[1]), cvtpk_s(p0[2], p0[3]), cvtpk_s(p0[4], p0[5]), cvtpk_s(p0[6], p0[7])}; \
        const u32x4 pw1 = {cvtpk_s(p0[8], p0[9]), cvtpk_s(p0[10], p0[11]), cvtpk_s(p0[12], p0[13]), cvtpk_s(p0[14], p0[15])}; \
        const u32x4 pw2 = {cvtpk_s(p1[0], p1[1]), cvtpk_s(p1[2], p1[3]), cvtpk_s(p1[4], p1[5]), cvtpk_s(p1[6], p1[7])}; \
        const u32x4 pw3 = {cvtpk_s(p1[8], p1[9]), cvtpk_s(p1[10], p1[11]), cvtpk_s(p1[12], p1[13]), cvtpk_s(p1[14], p1[15])}; \
        pv(o, vb0 + (vs) * VSLOT, __builtin_bit_cast(bf16x8, pw0), __builtin_bit_cast(bf16x8, pw1), __builtin_bit_cast(bf16x8, pw2), __builtin_bit_cast(bf16x8, pw3)); } while (0)
    int ks = 0, vs = 0, vsp = 0;
    if (wid < 4) {
        for (int t = 0; t < NT; ++t) {
            const int vsn = (vs == NVS - 1) ? 0 : vs + 1;
            if (t + 1 < NT) DMA_KV(t + 1, ks ^ 1, vsn);
            if (t < nvis) { qkt6(p0, p1, Kbase + ks * KSLOT, qr, r32, hi); SM_PV(vs); }
            WAIT_ALL_BAR();
            ks ^= 1; vs = vsn;
        }
    } else {
        for (int t = 0; t < NT; ++t) {
            const int vsn = (vs == NVS - 1) ? 0 : vs + 1;
            if (t + 1 < NT) DMA_KV(t + 1, ks ^ 1, vsn);
            if (t >= 1 && t - 1 < nvis) SM_PV(vsp);
            if (t < nvis) qkt6(p0, p1, Kbase + ks * KSLOT, qr, r32, hi);
            WAIT_ALL_BAR();
            ks ^= 1; vsp = vs; vs = vsn;
        }
        if (NT - 1 < nvis) SM_PV(vsp);
    }
#undef SM_PV
    { auto rr = __builtin_amdgcn_permlane32_swap(__float_as_uint(l), __float_as_uint(l), false, false); l = __uint_as_float(rr[0]) + __uint_as_float(rr[1]); }
    if (hi == 0) wsf[32 + r32] = l;
    asm volatile("s_waitcnt lgkmcnt(0)" ::: "memory");
    float rli[16];
#pragma unroll
    for (int r = 0; r < 16; ++r) rli[r] = __builtin_amdgcn_rcpf(wsf[32 + crow(r, hi)]);
    bf16* Ow = O + (rowbase + q0 + wid * 32) * 512 + h * 64;
    { bf16* stg = (bf16*)(shm + L_OST) + wid * 2048;
#pragma unroll
        for (int r = 0; r < 16; ++r) { const int orow = crow(r, hi);
#pragma unroll
            for (int d0 = 0; d0 < 2; ++d0) stg[orow * 64 + d0 * 32 + r32] = f2bf(o[d0][r] * rli[r]); }
        asm volatile("s_waitcnt lgkmcnt(0)" ::: "memory");
#pragma unroll
        for (int i = 0; i < 4; ++i) { const int row = i * 8 + (lane >> 3), ch = lane & 7; const u32x4 v = *(const u32x4*)(stg + row * 64 + ch * 8); *(u32x4*)(Ow + (long)row * 512 + ch * 8) = v; } }
    asm volatile("s_waitcnt lgkmcnt(0)\n\ts_barrier" ::: "memory");
#undef DMA_KV
}

constexpr int DQS = 592, D_KT = 0, D_QST = 0, D_END = 2 * 64 * DQS;
__device__ __forceinline__ void decode_unit(int b, int sp, const bf16* Q, const bf16* __restrict__ WUKn, const float* __restrict__ cache_kv, const float* __restrict__ cache_kr,
                                            const bf16* __restrict__ CKVN, const bf16* __restrict__ KPE, const bf16* __restrict__ Wkv_t, float* PART, float* ML, lptr shm) {
    int tid_ = threadIdx.x; asm volatile("" : "+v"(tid_)); const int tid = tid_, lane = tid & 63, fr = lane & 15, g = lane >> 4; const int w = __builtin_amdgcn_readfirstlane(tid >> 6);
    const lptr KT0 = shm + D_KT, QST = shm + D_QST + w * 16 * DQS;
    const float* kc = cache_kv + ((size_t)b * PAST + (size_t)sp * 256) * KVL; const float* kr = cache_kr + ((size_t)b * PAST + (size_t)sp * 256) * RD;
    f32x4 pre[9];
#define DEC_LOAD(t) do { const float* kc_ = kc + (size_t)(t) * 64 * KVL + tid * 4; _Pragma("unroll") for (int i_ = 0; i_ < 8; ++i_) pre[i_] = *(const f32x4*)(kc_ + i_ * 2048); \
        pre[8] = *(const f32x4*)(kr + (size_t)(t) * 64 * RD + tid * 4); } while (0)
#define DEC_STORE(KTp) do { _Pragma("unroll") for (int i_ = 0; i_ < 8; ++i_) { u32x2 w_; w_.x = cvtpk_s(pre[i_][0], pre[i_][1]); w_.y = cvtpk_s(pre[i_][2], pre[i_][3]); \
            *(LAS u32x2*)((KTp) + ((tid >> 6) + 8 * i_) * DQS + (tid & 63) * 8) = w_; } \
        { const int a_ = tid & 7; u32x2 w_; w_.x = cvtpk_s(pre[8][0], pre[8][1]); w_.y = cvtpk_s(pre[8][2], pre[8][3]); \
            *(LAS u32x2*)((KTp) + (tid >> 3) * DQS + 512 + 16 * (a_ & 3) + 8 * (a_ >> 2)) = w_; } } while (0)
    DEC_LOAD(0);
    __syncthreads();
    const bf16* qrow = Q + ((size_t)TP + b * SSEQ + fr) * NQ + w * 96;
    *(LAS u32x4*)(QST + fr * DQS + 512 + 16 * g) = *(const u32x4*)(qrow + 64 + 8 * g);
    { const bf16x8 qf0 = *(const bf16x8*)(qrow + 8 * g), qf1 = *(const bf16x8*)(qrow + 32 + 8 * g);
#pragma unroll 4
        for (int cb = 0; cb < 16; ++cb) { const bf16* wr_ = WUKn + (size_t)(16 * cb + fr) * 512 + w * 64 + 8 * g;
            f32x4 a = {0.f, 0.f, 0.f, 0.f};
            a = __builtin_amdgcn_mfma_f32_16x16x32_bf16(*(const bf16x8*)wr_, qf0, a, 0, 0, 0);
            a = __builtin_amdgcn_mfma_f32_16x16x32_bf16(*(const bf16x8*)(wr_ + 32), qf1, a, 0, 0, 0);
            u32x2 w_; w_.x = cvtpk_s(a[0], a[1]); w_.y = cvtpk_s(a[2], a[3]);
            *(LAS u32x2*)(QST + fr * DQS + (16 * cb + 4 * g) * 2) = w_; } }
    bf16x8 qf[9];
#pragma unroll
    for (int ds = 0; ds < 9; ++ds) qf[ds] = *(const LAS bf16x8*)(QST + fr * DQS + (32 * ds + 8 * g) * 2);
    __syncthreads();
    DEC_STORE(KT0);
    DEC_LOAD(1);
    __syncthreads();
    const int NT = 4 + (sp == 15 ? 1 : 0);
    float m = -1e30f, l = 0.f; f32x4 o[16];
#pragma unroll
    for (int cb = 0; cb < 16; ++cb) o[cb] = (f32x4){0.f, 0.f, 0.f, 0.f};
    for (int t = 0; t < NT; ++t) {
        const lptr KTp = KT0 + (t & 1) * 64 * DQS, KTn = KT0 + ((t + 1) & 1) * 64 * DQS;
        f32x4 s[4];
#pragma unroll
        for (int kb = 0; kb < 4; ++kb) s[kb] = (f32x4){0.f, 0.f, 0.f, 0.f};
#pragma unroll
        for (int ds = 0; ds < 9; ++ds)
#pragma unroll
            for (int kb = 0; kb < 4; ++kb) { const bf16x8 kf = *(const LAS bf16x8*)(KTp + (16 * kb + fr) * DQS + (32 * ds + 8 * g) * 2);
                s[kb] = __builtin_amdgcn_mfma_f32_16x16x32_bf16(kf, qf[ds], s[kb], 0, 0, 0); }
        if (t == 4) { s[1] = (f32x4){-1e30f, -1e30f, -1e30f, -1e30f}; s[2] = s[1]; s[3] = s[1]; }
        float rm = __builtin_fmaxf(__builtin_fmaxf(s[0][0], s[0][1]), __builtin_fmaxf(s[0][2], s[0][3]));
#pragma unroll
        for (int kb = 1; kb < 4; ++kb) rm = __builtin_fmaxf(rm, __builtin_fmaxf(__builtin_fmaxf(s[kb][0], s[kb][1]), __builtin_fmaxf(s[kb][2], s[kb][3])));
        rm = __builtin_fmaxf(rm, __shfl_xor(rm, 16)); rm = __builtin_fmaxf(rm, __shfl_xor(rm, 32));
        const float mn = __builtin_fmaxf(m, rm), f = __builtin_amdgcn_exp2f(m - mn); m = mn;
        float ls = 0.f;
#pragma unroll
        for (int kb = 0; kb < 4; ++kb)
#pragma unroll
            for (int i = 0; i < 4; ++i) { s[kb][i] = __builtin_amdgcn_exp2f(s[kb][i] - mn); ls += s[kb][i]; }
        l = l * f + ls;
#pragma unroll
        for (int cb = 0; cb < 16; ++cb) o[cb] *= f;
        u32x4 pw[2];
#pragma unroll
        for (int s2 = 0; s2 < 2; ++s2) pw[s2] = (u32x4){cvtpk_s(s[2 * s2][0], s[2 * s2][1]), cvtpk_s(s[2 * s2][2], s[2 * s2][3]), cvtpk_s(s[2 * s2 + 1][0], s[2 * s2 + 1][1]), cvtpk_s(s[2 * s2 + 1][2], s[2 * s2 + 1][3])};
#pragma unroll
        for (int cb = 0; cb < 16; ++cb)
#pragma unroll
            for (int s2 = 0; s2 < 2; ++s2) { const lptr va = KTp + (32 * s2 + 4 * g + (fr >> 2)) * DQS + (16 * cb + 4 * (fr & 3)) * 2;
                const s16x4 lo = __builtin_bit_cast(s16x4, __builtin_amdgcn_ds_read_tr16_b64_v4i16((LAS v4i16_t*)va));
                const s16x4 hh = __builtin_bit_cast(s16x4, __builtin_amdgcn_ds_read_tr16_b64_v4i16((LAS v4i16_t*)(va + 16 * DQS)));
                const bf16x8 vf = {lo[0], lo[1], lo[2], lo[3], hh[0], hh[1], hh[2], hh[3]};
                o[cb] = __builtin_amdgcn_mfma_f32_16x16x32_bf16(vf, __builtin_bit_cast(bf16x8, pw[s2]), o[cb], 0, 0, 0); }
        if (t + 1 < NT) {
            if (t + 1 < 4) { DEC_STORE(KTn); if (t + 2 < 4) DEC_LOAD(t + 2); }
            else {
                for (int idx = tid; idx < 16 * 36; idx += 512) { const int key = idx / 36, ch = idx - key * 36; const size_t row = (size_t)TP + b * SSEQ + key;
                    const u32x4 v = (ch < 32) ? *(const u32x4*)(CKVN + row * KVL + ch * 8) : *(const u32x4*)(KPE + row * RD + (ch - 32) * 8);
                    *(LAS u32x4*)(KTn + key * DQS + ch * 16) = v; }
                for (int idx = tid; idx < 48 * 37; idx += 512) { const int key = 16 + idx / 37, ch = idx % 37; *(LAS u32x4*)(KTn + key * DQS + ch * 16) = (u32x4){0u, 0u, 0u, 0u}; }
            }
        }
        __syncthreads();
    }
    l += __shfl_xor(l, 16); l += __shfl_xor(l, 32);
    f32x4 y[4];
#pragma unroll
    for (int db = 0; db < 4; ++db) y[db] = (f32x4){0.f, 0.f, 0.f, 0.f};
#pragma unroll
    for (int ks = 0; ks < 8; ++ks) { const u32x4 ob = {cvtpk_s(o[2 * ks][0], o[2 * ks][1]), cvtpk_s(o[2 * ks][2], o[2 * ks][3]), cvtpk_s(o[2 * ks + 1][0], o[2 * ks + 1][1]), cvtpk_s(o[2 * ks + 1][2], o[2 * ks + 1][3])};
#pragma unroll
        for (int db = 0; db < 4; ++db) { const bf16* wrow = Wkv_t + (size_t)(512 + 64 * w + 16 * db + fr) * KVL + 32 * ks + 4 * g;
            const u32x2 w0 = *(const u32x2*)wrow, w1 = *(const u32x2*)(wrow + 16); const u32x4 wa = {w0.x, w0.y, w1.x, w1.y};
            y[db] = __builtin_amdgcn_mfma_f32_16x16x32_bf16(__builtin_bit_cast(bf16x8, wa), __builtin_bit_cast(bf16x8, ob), y[db], 0, 0, 0); } }
    const size_t prow = ((size_t)(b * 16 + sp) * 128 + 16 * w + fr);
#pragma unroll
    for (int db = 0; db < 4; ++db) *(f32x4*)(PART + prow * 64 + 16 * db + 4 * g) = y[db];
    if (g == 0) { ML[prow * 2] = m; ML[prow * 2 + 1] = l; }
#undef DEC_LOAD
#undef DEC_STORE
}

constexpr int M_UH = 0, M_WDW = 62 * 1024, M_END = M_WDW + 31 * 2048;
template <int NR, bool COMBINE> __device__ __forceinline__ void mix_rows(lptr UH, const LAS float* WDW, int lrow0, size_t grow0, const float* bdw, const float* gcn, const float* bcn,
                                                           const bf16* __restrict__ OMLA, bf16* MIX, int lane, const float* PART = nullptr, const float* ML = nullptr) {
    u32x4 om[NR];
#pragma unroll
    for (int r = 0; r < NR; ++r) om[r] = COMBINE ? (u32x4){0u, 0u, 0u, 0u} : *(const u32x4*)(OMLA + (grow0 + r) * 512 + 8 * lane);
    float acc[NR][8];
#pragma unroll
    for (int r = 0; r < NR; ++r)
#pragma unroll
        for (int e = 0; e < 8; ++e) acc[r][e] = bdw[e];
    f32x4 wl[NR][2];
#pragma unroll
    for (int r = 0; r < NR; ++r) { wl[r][0] = (f32x4){0.f, 0.f, 0.f, 0.f}; wl[r][1] = wl[r][0]; }
#pragma unroll 1
    for (int i0 = 0; i0 < NR + CW - 1; i0 += NR) {
#pragma unroll
        for (int ii = 0; ii < NR; ++ii) { const int i = i0 + ii; const int iw = i < CW ? i : CW - 1, iu = i < NR + CW - 1 ? i : NR + CW - 2;
            const f32x4 wa_ = *(const LAS f32x4*)(WDW + iw * 512 + 8 * lane), wb_ = *(const LAS f32x4*)(WDW + iw * 512 + 8 * lane + 4);
            const float keep = i < CW ? 1.0f : 0.0f; wl[ii][0] = wa_ * keep; wl[ii][1] = wb_ * keep;
            const u32x4 uv = *(const LAS u32x4*)(UH + (lrow0 + iu) * 1024 + 16 * lane);
            const float f0 = __uint_as_float(uv.x << 16), f1 = __uint_as_float(uv.x & 0xffff0000u), f2 = __uint_as_float(uv.y << 16), f3 = __uint_as_float(uv.y & 0xffff0000u),
                        f4 = __uint_as_float(uv.z << 16), f5 = __uint_as_float(uv.z & 0xffff0000u), f6 = __uint_as_float(uv.w << 16), f7 = __uint_as_float(uv.w & 0xffff0000u);
#pragma unroll
            for (int r = 0; r < NR; ++r) { const f32x4 wa = wl[(ii - r + NR) % NR][0], wb = wl[(ii - r + NR) % NR][1];
                acc[r][0] += f0 * wa[0]; acc[r][1] += f1 * wa[1]; acc[r][2] += f2 * wa[2]; acc[r][3] += f3 * wa[3];
                acc[r][4] += f4 * wb[0]; acc[r][5] += f5 * wb[1]; acc[r][6] += f6 * wb[2]; acc[r][7] += f7 * wb[3]; } }
    }
#pragma unroll
    for (int r = 0; r < NR; ++r) {
        float s = 0.f;
#pragma unroll
        for (int e = 0; e < 8; ++e) s += acc[r][e];
        const float mu = wave_sum(s) * (1.0f / CC);
        float q = 0.f;
#pragma unroll
        for (int e = 0; e < 8; ++e) { acc[r][e] -= mu; q += acc[r][e] * acc[r][e]; }
        const float rs = rsqrtf(wave_sum(q) * (1.0f / CC) + EPS);
        float q2 = 0.f;
#pragma unroll
        for (int e = 0; e < 8; ++e) { const float ln = acc[r][e] * rs * gcn[e] + bcn[e]; const float co = ln * __builtin_amdgcn_rcpf(1.f + __builtin_amdgcn_exp2f(-1.4426950408889634f * ln)); acc[r][e] = co; q2 += co * co; }
        const float r2 = rsqrtf(wave_sum(q2) * (1.0f / CC) + EPS);
        const size_t row = grow0 + r;
        u32x4 ov; ov.x = cvtpk_s(acc[r][0] * r2, acc[r][1] * r2); ov.y = cvtpk_s(acc[r][2] * r2, acc[r][3] * r2); ov.z = cvtpk_s(acc[r][4] * r2, acc[r][5] * r2); ov.w = cvtpk_s(acc[r][6] * r2, acc[r][7] * r2);
        *(u32x4*)(MIX + row * DM + 512 + 8 * lane) = ov;
        float x[8];
        if constexpr (COMBINE) { const int srow = (int)(row - TP), bb = srow >> 4, tok = srow & 15, hh = lane >> 3, d0 = 8 * (lane & 7);
            float mv[16], lv[16], M = -1e30f;
#pragma unroll
            for (int s2 = 0; s2 < 16; ++s2) { const size_t pr = ((size_t)(bb * 16 + s2) * 128 + 16 * hh + tok); mv[s2] = ML[pr * 2]; lv[s2] = ML[pr * 2 + 1]; M = __builtin_fmaxf(M, mv[s2]); }
            f32x4 a0 = {0.f, 0.f, 0.f, 0.f}, a1 = a0; float L = 0.f;
#pragma unroll
            for (int sh = 0; sh < 2; ++sh) {
#pragma unroll
                for (int s3 = 0; s3 < 8; ++s3) { const int s2 = 8 * sh + s3; const size_t pr = ((size_t)(bb * 16 + s2) * 128 + 16 * hh + tok); const float wgt = __builtin_amdgcn_exp2f(mv[s2] - M);
                    L += wgt * lv[s2]; a0 += *(const f32x4*)(PART + pr * 64 + d0) * wgt; a1 += *(const f32x4*)(PART + pr * 64 + d0 + 4) * wgt; }
                asm volatile("" ::: "memory"); }
            const float rl = 1.0f / L;
            x[0] = a0[0] * rl; x[1] = a0[1] * rl; x[2] = a0[2] * rl; x[3] = a0[3] * rl; x[4] = a1[0] * rl; x[5] = a1[1] * rl; x[6] = a1[2] * rl; x[7] = a1[3] * rl;
        } else { const u32x4 o4 = om[r];
            x[0] = __uint_as_float(o4.x << 16); x[1] = __uint_as_float(o4.x & 0xffff0000u); x[2] = __uint_as_float(o4.y << 16); x[3] = __uint_as_float(o4.y & 0xffff0000u);
            x[4] = __uint_as_float(o4.z << 16); x[5] = __uint_as_float(o4.z & 0xffff0000u); x[6] = __uint_as_float(o4.w << 16); x[7] = __uint_as_float(o4.w & 0xffff0000u); }
        float q3 = 0.f;
#pragma unroll
        for (int e = 0; e < 8; ++e) q3 += x[e] * x[e];
        const float r3 = rsqrtf(wave_sum(q3) * (1.0f / 512.0f) + EPS);
        u32x4 o2; o2.x = cvtpk_s(x[0] * r3, x[1] * r3); o2.y = cvtpk_s(x[2] * r3, x[3] * r3); o2.z = cvtpk_s(x[4] * r3, x[5] * r3); o2.w = cvtpk_s(x[6] * r3, x[7] * r3);
        *(u32x4*)(MIX + row * DM + 8 * lane) = o2;
    }
}
#undef SBAR
}

constexpr int NWAVES = 8;
#ifndef MK_N_LAUNCHES
#define MK_N_LAUNCHES 1
#endif
constexpr int NPHASE = 11;
#ifndef MK_DUP
#define MK_DUP 0
#endif
constexpr int N_LAUNCHES = MK_N_LAUNCHES;

constexpr size_t MiB = 1u << 20;
constexpr size_t WS_CTL = 0, CTL_ZERO_BYTES = 512 * 1024;
constexpr size_t WS_W1 = 1 * MiB, WS_WQ = 5 * MiB, WS_WKV = 6 * MiB, WS_WO = 7 * MiB, WS_WGU = 9 * MiB, WS_WD = 20 * MiB, WS_WUKN = 25 * MiB + 512 * 1024, WS_ROPE = 26 * MiB;
constexpr size_t WS_XN = 27 * MiB, WS_MIX = WS_XN, WS_CQ = 60 * MiB, WS_CKVN = 73 * MiB, WS_KPE = 82 * MiB, WS_U = 84 * MiB, WS_Q = 101 * MiB, WS_ACT = 27 * MiB;
constexpr size_t WS_H2 = 126 * MiB;
constexpr size_t WS_SLAB6 = 208 * MiB, WS_SLAB8 = 212 * MiB;
constexpr int MT6 = 4, MT8 = 4;
constexpr size_t WS_KN = 126 * MiB, WS_V = 142 * MiB, WS_OMLA = 158 * MiB, WS_HB = 175 * MiB, WS_PART = 208 * MiB, WS_ML = 240 * MiB, WS_END = 241 * MiB;
static_assert(WS_W1 + (size_t)N1 * DM * 2 <= WS_WQ && WS_WQ + (size_t)NQ * QL * 2 <= WS_WKV && WS_WKV + (size_t)NKV * KVL * 2 <= WS_WO && WS_WO + (size_t)DM * DM * 2 <= WS_WGU &&
              WS_WGU + (size_t)NGU * DM * 2 <= WS_WD && WS_WD + (size_t)DM * DFF * 2 <= WS_WUKN && WS_WUKN + (size_t)KVL * 512 * 2 <= WS_ROPE && WS_ROPE + (size_t)NPOS * 16 * 8 <= WS_XN, "weight map");
static_assert(WS_XN + (size_t)T * DM * 2 <= WS_CQ && WS_CQ + (size_t)T * QL * 2 <= WS_CKVN && WS_CKVN + (size_t)T * KVL * 2 <= WS_KPE && WS_KPE + (size_t)T * RD * 2 <= WS_U &&
              WS_U + (size_t)T * CC * 2 <= WS_Q && WS_Q + (size_t)T * NQ * 2 <= WS_KN && WS_ACT + (size_t)T * DFF * 2 <= WS_KN && WS_KN + (size_t)TP * 512 * 2 <= WS_V &&
              WS_V + (size_t)TP * 512 * 2 <= WS_OMLA && WS_OMLA + (size_t)T * 512 * 2 <= WS_HB && WS_HB + (size_t)T * DM * 2 <= WS_PART && WS_PART + (size_t)256 * 128 * 256 * 4 <= WS_ML &&
              WS_ML + (size_t)256 * 128 * 2 * 4 <= WS_END, "activation map");
constexpr int CW_TMO = 0, CW_CODE = 1, CW_BAR = 4096, CW_CNT6 = 8192, CW_SSQ_Q = 16384, CW_SSQ_H = CW_SSQ_Q + T;
static_assert((size_t)(CW_SSQ_H + T) * 4 <= CTL_ZERO_BYTES, "CTL words inside the memset region");
constexpr int RING_OFF = 0, RING_BYTES = 131072, EX_OFF = RING_BYTES, LDSCTL_OFF = EX_OFF + 4096, MISC_OFF = LDSCTL_OFF + 320, LDS_BYTES = 147456;
static_assert(MISC_OFF + 128 <= LDS_BYTES && att::L_END <= RING_BYTES && att::D_END <= RING_BYTES && att::M_END <= RING_BYTES, "LDS map");

typedef unsigned short bf16;
typedef unsigned v4u __attribute__((ext_vector_type(4)));
typedef float f32x4 __attribute__((ext_vector_type(4)));
typedef GAS unsigned gu32;
#define RLX_AGENT __ATOMIC_RELAXED, __HIP_MEMORY_SCOPE_AGENT
#define LDS_WAIT() asm volatile("s_waitcnt lgkmcnt(0)" ::: "memory")
#define VM_WAIT() asm volatile("s_waitcnt vmcnt(0)" ::: "memory")
__device__ __forceinline__ unsigned f2bf(float f) { unsigned u = __builtin_bit_cast(unsigned, f); return (u + 0x7fffu + ((u >> 16) & 1u)) >> 16; }
__device__ __forceinline__ unsigned pk2(float lo, float hi) { return f2bf(lo) | (f2bf(hi) << 16); }

#define XB_TMO      128
#define XB_XCNT(j)  (256  + 64 * (j))
#define XB_XSUB(j)  (1280 + 64 * (j))
#define XB_XGEN(j)  (2304 + 64 * (j))
#define XB_TOP      3328
#define XB_TOPGEN   3392
#define XCD_BAR_WORDS 3456
#define XB_SPIN_CAP (1u << 18)

__device__ __forceinline__ unsigned xb_ld(unsigned* p)              { return __hip_atomic_load(p, __ATOMIC_RELAXED, __HIP_MEMORY_SCOPE_AGENT); }
__device__ __forceinline__ unsigned xb_add(unsigned* p, unsigned v) { return __hip_atomic_fetch_add(p, v, __ATOMIC_RELAXED, __HIP_MEMORY_SCOPE_AGENT); }
__device__ __forceinline__ unsigned xb_xcc_id() { return (unsigned)__builtin_amdgcn_s_getreg((3 << 11) | 20) & 0xFu; }
#define XB_SPIN(cond, bar) do { unsigned _sp = 0; while (cond) { __builtin_amdgcn_s_sleep(1); \
    if ((++_sp & 255u) == 0u) { if (xb_ld(&(bar)[XB_TMO])) break; if (_sp > XB_SPIN_CAP) { atomicAdd(&(bar)[XB_TMO], 1u); break; } } } } while (0)

struct XcdBarrier {
    unsigned* bar; unsigned x;
    volatile LAS unsigned* st;
};

__device__ __forceinline__ XcdBarrier xcd_barrier_post(unsigned* bar, volatile LAS unsigned* st) {
    XcdBarrier b; b.bar = bar; b.x = xb_xcc_id(); b.st = st;
    if (threadIdx.x == 0) (void)xb_add(&bar[XB_XCNT(b.x)], 1u);
    return b;
}
__device__ __forceinline__ void xcd_barrier_complete(unsigned* bar, unsigned x, unsigned& nloc, unsigned& nx) {
    const unsigned G = gridDim.x * gridDim.y * gridDim.z;
    unsigned sum, cnt, mine, sp = 0u;
    for (;;) {
        sum = 0u; cnt = 0u; mine = 0u;
#pragma unroll
        for (unsigned j = 0; j < 16; ++j) { const unsigned c = xb_ld(&bar[XB_XCNT(j)]); sum += c; cnt += (c > 0u) ? 1u : 0u; mine = (j == x) ? c : mine; }
        if (sum == G) break;
        __builtin_amdgcn_s_sleep(1);
        if ((++sp & 255u) == 0u) { if (xb_ld(&bar[XB_TMO])) break; if (sp > XB_SPIN_CAP) { atomicAdd(&bar[XB_TMO], 1u); break; } }
    }
    nloc = mine > 0u ? mine : 1u; nx = cnt > 0u ? cnt : 1u;
}

__device__ __forceinline__ void xcd_barrier(const XcdBarrier& b) {
    asm volatile("s_waitcnt vmcnt(0)" ::: "memory");
    __syncthreads();
    if (threadIdx.x == 0) {
        unsigned* bar = b.bar;
        __builtin_amdgcn_s_waitcnt(0);
        unsigned nloc = b.st[0], nx = b.st[1];
        if (nloc == 0u) { xcd_barrier_complete(bar, b.x, nloc, nx); b.st[0] = nloc; b.st[1] = nx; }
        const unsigned old = xb_add(&bar[XB_XSUB(b.x)], 1u);
        const unsigned gen = old / nloc;
        if (old + 1u == (gen + 1u) * nloc) {
            __builtin_amdgcn_fence(__ATOMIC_RELEASE, "agent");
            asm volatile("s_waitcnt vmcnt(0)" ::: "memory");
            const unsigned og = xb_add(&bar[XB_TOP], 1u);
            const unsigned tg = og / nx;
            if (og + 1u == (tg + 1u) * nx) xb_add(&bar[XB_TOPGEN], 1u);
            else XB_SPIN(xb_ld(&bar[XB_TOPGEN]) == tg, bar);
            __builtin_amdgcn_fence(__ATOMIC_ACQUIRE, "agent");
            xb_add(&bar[XB_XGEN(b.x)], 1u);
            asm volatile("s_waitcnt vmcnt(0)" ::: "memory");
        } else {
            XB_SPIN(xb_ld(&bar[XB_XGEN(b.x)]) == gen, bar);
            __builtin_amdgcn_fence(__ATOMIC_ACQUIRE, "agent");
            asm volatile("s_waitcnt vmcnt(0)" ::: "memory");
        }
    }
    __syncthreads();
}


template <class Src> __device__ __forceinline__ void p0_transpose_item(const Src& S, int K, bf16* WT, LAS float* scr, int item, int lane) {
    const int nblk = Src::N / 32, kb = item / nblk, nb = item % nblk, k0 = 64 * kb, n0 = 32 * nb;
    float tv[32];
#pragma unroll
    for (int i = 0; i < 32; ++i) tv[i] = S.load(k0 + 2 * i + (lane >> 5), n0 + (lane & 31));
#pragma unroll
    for (int i = 0; i < 32; ++i) scr[(2 * i + (lane >> 5)) * 33 + (lane & 31)] = tv[i];
    LDS_WAIT(); asm volatile("" ::: "memory");
    const int c = lane & 7;
#pragma unroll
    for (int j = 0; j < 4; ++j) { const int n = (lane >> 3) + 8 * j; const LAS float* s = scr + (8 * c) * 33 + n;
        v4u o; o.x = pk2(s[0 * 33], s[1 * 33]); o.y = pk2(s[2 * 33], s[3 * 33]); o.z = pk2(s[4 * 33], s[5 * 33]); o.w = pk2(s[6 * 33], s[7 * 33]);
        *(GAS v4u*)(WT + (size_t)(n0 + n) * K + k0 + 8 * c) = o; }
    LDS_WAIT(); asm volatile("" ::: "memory");
}
struct SrcW1 { static constexpr int N = N1; const float* w;
    __device__ __forceinline__ float load(int k, int n) const { int col;
        if (n < 256) col = QL + n;
        else if (n < 640) col = n - 256;
        else if (n < 672) { const int p = n - 640; col = QL + KVL + ((p >> 2) & 1) * 16 + 4 * (p >> 3) + (p & 3); }
        else if (n < 768) return 0.f;
        else { const int q = (n - 768) & 255, t = (n - 768) >> 8; col = QL + KVL + RD + ((q >> 7) ? CC : 0) + 128 * t + (q & 127); }
        return w[(size_t)k * INW + col]; } };
struct SrcWq { static constexpr int N = NQ; const float* w; const float* g;
    __device__ __forceinline__ float load(int k, int n) const { const int h = n / 96, r = n - h * 96; int col = h * 96 + r;
        if (r >= 64) { const int p = r - 64; col = h * 96 + 64 + ((p >> 2) & 1) * 16 + 4 * (p >> 3) + (p & 3); }
        return w[(size_t)k * NQ + col] * g[k]; } };
struct SrcWkv { static constexpr int N = NKV; const float* w;
    __device__ __forceinline__ float load(int k, int n) const { return w[(size_t)k * 512 + (n & 511)]; } };
struct SrcWo { static constexpr int N = DM; const float* w; const float* g;
    __device__ __forceinline__ float load(int k, int n) const { return w[(size_t)k * DM + n] * g[k & 511]; } };
struct SrcWgu { static constexpr int N = NGU; const float* w; const float* ln;
    __device__ __forceinline__ float load(int k, int n) const { const int t = n >> 8, q = n & 255, j = 128 * t + (q & 127); return w[(size_t)k * DFF + j] * ln[k]; } };
struct SrcWd { static constexpr int N = DM; const float* w;
    __device__ __forceinline__ float load(int k, int n) const { return w[(size_t)k * DM + n]; } };

__device__ __forceinline__ void rms_row(const float* xrow, const float* g, bf16* out_bf, float* out_f32, int lane, const float* slab = nullptr, int nslab = 0, const bf16* hbrow = nullptr) {
    const GAS f32x4* xr = (const GAS f32x4*)xrow + lane; const GAS f32x4* gr = (const GAS f32x4*)g + lane;
    f32x4 v[4]; float s = 0.f;
    if (hbrow) {
#pragma unroll
        for (int j = 0; j < 4; ++j) { const unsigned long long h = ((const GAS unsigned long long*)hbrow + lane)[64 * j]; const unsigned lo = (unsigned)h, hi = (unsigned)(h >> 32);
            v[j] = (f32x4){__uint_as_float(lo << 16), __uint_as_float(lo & 0xffff0000u), __uint_as_float(hi << 16), __uint_as_float(hi & 0xffff0000u)}; }
    } else {
#pragma unroll
        for (int j = 0; j < 4; ++j) v[j] = xr[64 * j];
    }
    if (slab) for (int sl = 0; sl < nslab; ++sl) { const GAS f32x4* sr = (const GAS f32x4*)(slab + (size_t)sl * 256 * DM) + lane;
#pragma unroll
        for (int j = 0; j < 4; ++j) v[j] += sr[64 * j]; }
#pragma unroll
    for (int j = 0; j < 4; ++j) s += (v[j].x * v[j].x + v[j].y * v[j].y) + (v[j].z * v[j].z + v[j].w * v[j].w);
    const float r = rsqrtf(att::wave_sum(s) * (1.0f / DM) + EPS);
#pragma unroll
    for (int j = 0; j < 4; ++j) { const f32x4 o = v[j] * r * gr[64 * j];
        if (out_bf) { GAS unsigned long long* o8 = (GAS unsigned long long*)out_bf + lane; o8[64 * j] = (unsigned long long)pk2(o.x, o.y) | ((unsigned long long)pk2(o.z, o.w) << 32); }
        else ((GAS f32x4*)out_f32 + lane)[64 * j] = o; }
}

template <bool IN_BF16, bool OUT_BF16> __device__ __forceinline__ void rms_rows2(const void* ina, const void* inb, const float* g, void* outa, void* outb, int lane) {
    f32x4 v[2][4];
#pragma unroll
    for (int rr = 0; rr < 2; ++rr) { const void* in = rr ? inb : ina;
#pragma unroll
        for (int j = 0; j < 4; ++j) {
            if (IN_BF16) { const unsigned long long h = ((const GAS unsigned long long*)in + lane)[64 * j]; const unsigned lo = (unsigned)h, hi = (unsigned)(h >> 32);
                v[rr][j] = (f32x4){__uint_as_float(lo << 16), __uint_as_float(lo & 0xffff0000u), __uint_as_float(hi << 16), __uint_as_float(hi & 0xffff0000u)}; }
            else v[rr][j] = ((const GAS f32x4*)in + lane)[64 * j]; } }
    const GAS f32x4* gr = (const GAS f32x4*)g + lane;
#pragma unroll
    for (int rr = 0; rr < 2; ++rr) { float s = 0.f;
#pragma unroll
        for (int j = 0; j < 4; ++j) s += (v[rr][j].x * v[rr][j].x + v[rr][j].y * v[rr][j].y) + (v[rr][j].z * v[rr][j].z + v[rr][j].w * v[rr][j].w);
        const float r = rsqrtf(att::wave_sum(s) * (1.0f / DM) + EPS); void* out = rr ? outb : outa;
#pragma unroll
        for (int j = 0; j < 4; ++j) { const f32x4 o = v[rr][j] * r * gr[64 * j];
            if (OUT_BF16) ((GAS unsigned long long*)out + lane)[64 * j] = (unsigned long long)pk2(o.x, o.y) | ((unsigned long long)pk2(o.z, o.w) << 32);
            else ((GAS f32x4*)out + lane)[64 * j] = o; } }
}

struct Args { const float* in[24]; float* out; unsigned char* ws; int ph_lo, ph_hi; };
__global__ void __launch_bounds__(NWAVES * 64, 2) mk_fwd(Args args) {
    extern __shared__ __attribute__((aligned(16))) unsigned char lds[];
    LAS unsigned char* const ldsp = (LAS unsigned char*)lds;
    volatile LAS unsigned* const MISC = (volatile LAS unsigned*)(ldsp + MISC_OFF);
    const int tid0 = threadIdx.x, wave = __builtin_amdgcn_readfirstlane(tid0 >> 6);
#define PHASE_IDS() int tid = tid0; asm volatile("" : "+v"(tid)); const int lane = tid & 63; const int gtid = (int)blockIdx.x * (NWAVES * 64) + tid; (void)lane; (void)gtid
    const int G = gridDim.x; const int vcu = (G % 8 == 0) ? ((int)blockIdx.x % 8) * (G / 8) + (int)blockIdx.x / 8 : (int)blockIdx.x;
    unsigned char* const ws = args.ws; float* const out = args.out;
    gu32* const ctl = (gu32*)(ws + WS_CTL);
    const float *x_p = args.in[0], *x_s = args.in[1], *cache_kv = args.in[2], *cache_kr = args.in[3], *st_conv = args.in[4], *ln_mix = args.in[5], *w_in = args.in[6], *g_q = args.in[7],
                *w_uq = args.in[8], *g_kv = args.in[9], *w_uk = args.in[10], *w_uv = args.in[11], *w_dw = args.in[12], *b_dw = args.in[13], *g_cn = args.in[14], *b_cn = args.in[15],
                *g_om = args.in[16], *g_oc = args.in[17], *w_out = args.in[18], *ln_ffn = args.in[19], *w_gate = args.in[20], *w_up = args.in[21], *w_down = args.in[22], *g_final = args.in[23];
    bf16 *W1t = (bf16*)(ws + WS_W1), *Wq_t = (bf16*)(ws + WS_WQ), *Wkv_t = (bf16*)(ws + WS_WKV), *Wo_t = (bf16*)(ws + WS_WO), *Wgu_t = (bf16*)(ws + WS_WGU), *Wd_t = (bf16*)(ws + WS_WD), *WUKn = (bf16*)(ws + WS_WUKN);
    float* ROPE = (float*)(ws + WS_ROPE);
    bf16 *XN = (bf16*)(ws + WS_XN), *MIX = (bf16*)(ws + WS_MIX), *CQ = (bf16*)(ws + WS_CQ), *CKVN = (bf16*)(ws + WS_CKVN), *KPE = (bf16*)(ws + WS_KPE), *U = (bf16*)(ws + WS_U), *Q = (bf16*)(ws + WS_Q),
         *ACT = (bf16*)(ws + WS_ACT), *KN = (bf16*)(ws + WS_KN), *V = (bf16*)(ws + WS_V), *OMLA = (bf16*)(ws + WS_OMLA), *HB = (bf16*)(ws + WS_HB);
    float *PART = (float*)(ws + WS_PART), *ML = (float*)(ws + WS_ML), *SSQ_Q = (float*)(ws + WS_CTL) + CW_SSQ_Q, *SSQ_H = (float*)(ws + WS_CTL) + CW_SSQ_H, *Y = out + O_Y;

    for (int u = tid0; u < (LDS_BYTES - LDSCTL_OFF) / 4; u += NWAVES * 64) ((LAS unsigned*)(ldsp + LDSCTL_OFF))[u] = 0u;
    __syncthreads();
    XcdBarrier bar; bar.bar = (unsigned*)(ctl + CW_BAR); bar.x = 0; bar.st = nullptr;
    if (N_LAUNCHES != NPHASE) bar = xcd_barrier_post((unsigned*)(ctl + CW_BAR), MISC + 8);
#define GRID_BAR() do { if (N_LAUNCHES == NPHASE) { if (tid0 == 0) __hip_atomic_store(ctl + CW_TMO, 0xBADBA0u, RLX_AGENT); } else { xcd_barrier(bar); } } while (0)
    const int lo = args.ph_lo, hi = args.ph_hi;
#define IN(k) (lo <= (k) && (k) < hi)
#define BOTH(k) (IN(k) && IN((k) + 1))
    const int gw = vcu * NWAVES + wave, NGW = G * NWAVES, NGT = G * NWAVES * 64;
    f32x4 preacc[2][2][4][2], preacc9[2][2][4][2];
#define PRELOAD(Sx, Ex, PA) do { pg8::Unit u_; if ((Sx).next(0, u_)) { int t_ = tid0; asm volatile("" : "+v"(t_)); (Ex).init(PA, u_, wave >> 2, wave & 3, t_ & 15, (t_ >> 4) & 3); } } while (0)

    for (int rep_ = 0; rep_ < 1 + ((MK_DUP >> 0) & 1); ++rep_)
    if (IN(0)) {
        PHASE_IDS();
        LAS float* scr = (LAS float*)(ldsp + RING_OFF + wave * 16384);
        constexpr int I_1 = (DM / 64) * (N1 / 32), I_Q = (QL / 64) * (NQ / 32), I_KV = (KVL / 64) * (NKV / 32), I_O = (DM / 64) * (DM / 32), I_GU = (DM / 64) * (NGU / 32), I_D = (DFF / 64) * (DM / 32);
        constexpr int NITEMS = I_1 + I_Q + I_KV + I_O + I_GU + I_D;
        for (int it = gw; it < NITEMS; it += NGW) {
            int r = it;
            if (r < I_1) { p0_transpose_item(SrcW1{w_in}, DM, W1t, scr, r, lane); continue; } r -= I_1;
            if (r < I_Q) { p0_transpose_item(SrcWq{w_uq, g_q}, QL, Wq_t, scr, r, lane); continue; } r -= I_Q;
            if (r < I_KV) { const bool second = (r % (NKV / 32)) * 32 >= 512; p0_transpose_item(SrcWkv{second ? w_uv : w_uk}, KVL, Wkv_t, scr, r, lane); continue; } r -= I_KV;
            if (r < I_O) { const bool second = (r / (DM / 32)) * 64 >= 512; p0_transpose_item(SrcWo{w_out, second ? g_oc : g_om}, DM, Wo_t, scr, r, lane); continue; } r -= I_O;
            if (r < I_GU) { const bool up = (((r % (NGU / 32)) * 32) & 255) >= 128; p0_transpose_item(SrcWgu{up ? w_up : w_gate, ln_ffn}, DM, Wgu_t, scr, r, lane); continue; } r -= I_GU;
            p0_transpose_item(SrcWd{w_down}, DFF, Wd_t, scr, r, lane);
        }
        for (int m = gw; m < TP; m += 2 * NGW) { const int m2 = (m + NGW < TP) ? m + NGW : m; rms_rows2<false, true>(x_p + (size_t)m * DM, x_p + (size_t)m2 * DM, ln_mix, XN + (size_t)m * DM, XN + (size_t)m2 * DM, lane); }
        for (int m = TP + gw; m < T; m += NGW) rms_row(x_s + (size_t)(m - TP) * DM, ln_mix, XN + (size_t)m * DM, nullptr, lane);
        for (int i = gtid; i < NPOS * 16; i += NGT) { const int pi = i >> 4, fi = i & 15; const int pos = pi < SEQ ? pi : PAST + (pi - SEQ);
            const double ang = (double)pos * exp2(-(double)fi * 0.8304820237218406);
            ROPE[2 * i] = (float)cos(ang); ROPE[2 * i + 1] = (float)sin(ang); }
        for (int i = gtid; i < KVL * 512 / 4; i += NGT) { const f32x4 v = *(const f32x4*)(w_uk + (size_t)i * 4); *(unsigned long long*)(WUKn + (size_t)i * 4) = (unsigned long long)pk2(v.x, v.y) | ((unsigned long long)pk2(v.z, v.w) << 32); }
        for (int i = gtid; i < SBATCH * (CST - SSEQ) * CC / 4; i += NGT) { const int c4 = i % (CC / 4), r = (i / (CC / 4)) % (CST - SSEQ), b = i / ((CC / 4) * (CST - SSEQ));
            *(f32x4*)(out + O_CVS + ((size_t)b * CST + r) * CC + c4 * 4) = *(const f32x4*)(st_conv + ((size_t)b * CST + SSEQ + r) * CC + c4 * 4); }
        if (BOTH(0)) GRID_BAR();
        if ((MK_DUP >> 20) & 1) { GRID_BAR(); GRID_BAR(); GRID_BAR(); GRID_BAR(); }
    }
    if (IN(1)) {
        pg8::Gemm g{XN, W1t, T, N1, DM}; pg8::StaticOrder S; S.init(T, N1, G, (int)blockIdx.x);
        if ((MK_DUP >> 1) & 1) { pg8::EpiProj Ed{CKVN, CQ, KPE, U, out, (float*)(ws + WS_ML), g_kv, ROPE, (LAS float*)(ldsp + EX_OFF)};
            pg8::gemm_phase<pg8::EpiProj, pg8::StaticOrder, true, true>(ldsp + RING_OFF, g, S, Ed, preacc, false); GRID_BAR(); }
        pg8::EpiProj E{CKVN, CQ, KPE, U, out, SSQ_Q, g_kv, ROPE, (LAS float*)(ldsp + EX_OFF)};
        pg8::gemm_phase<pg8::EpiProj, pg8::StaticOrder, true, true>(ldsp + RING_OFF, g, S, E, preacc, false);
        if (BOTH(1)) GRID_BAR();
    }
    for (int rep_ = 0; rep_ < 1 + ((MK_DUP >> 2) & 1); ++rep_)
    if (IN(2)) {
        { pg8::Gemm g{CQ, Wq_t, T, NQ, QL}; pg8::StaticOrder S; S.init(T, NQ, G, (int)blockIdx.x);
          pg8::EpiQ E{Q, SSQ_Q, ROPE};
          pg8::gemm_phase<pg8::EpiQ, pg8::StaticOrder, true, true>(ldsp + RING_OFF, g, S, E, preacc, false); }
        { pg8::Gemm g{CKVN, Wkv_t, TP, NKV, KVL}; pg8::StaticOrder S; S.init(TP, NKV, G, (int)blockIdx.x);
          pg8::EpiBf16 E{KN, 512, 512, (size_t)(WS_V - WS_KN) / 2};
          pg8::gemm_phase<pg8::EpiBf16, pg8::StaticOrder, true, true>(ldsp + RING_OFF, g, S, E, preacc, false); }
        if (BOTH(2)) GRID_BAR();
    }
    for (int rep_ = 0; rep_ < 1 + ((MK_DUP >> 3) & 1); ++rep_)
    if (IN(3)) {
        PHASE_IDS();
        if (rep_ == 0 || ((MK_DUP >> 16) & 1) == 0) for (int p = vcu; p < 256; p += G) { const int bh = p >> 2, s = p & 3;
            att::prompt_unit(bh >> 3, bh & 7, 7 - s, Q, KN, KPE, V, OMLA, (char*)lds + RING_OFF);
            att::prompt_unit(bh >> 3, bh & 7, s, Q, KN, KPE, V, OMLA, (char*)lds + RING_OFF); }
        if (rep_ == 0 || ((MK_DUP >> 17) & 1) == 0) for (int p = vcu; p < 256; p += G) att::decode_unit(p >> 4, p & 15, Q, WUKn, cache_kv, cache_kr, CKVN, KPE, Wkv_t, PART, ML, (att::lptr)(ldsp + RING_OFF));
        if (IN(3) && IN(5)) GRID_BAR();
    }
    for (int rep_ = 0; rep_ < 1 + ((MK_DUP >> 5) & 1); ++rep_)
    if (IN(5)) {
        PHASE_IDS();
        const att::lptr UH = (att::lptr)(ldsp + RING_OFF + att::M_UH); LAS float* WDW = (LAS float*)(ldsp + RING_OFF + att::M_WDW);
        __syncthreads();
        { f32x4 tw[8];
#pragma unroll
          for (int k = 0; k < 8; ++k) { const int i = tid + 512 * k; tw[k] = *(const f32x4*)(w_dw + 4 * (i < CW * CC / 4 ? i : 0)); }
#pragma unroll
          for (int k = 0; k < 8; ++k) { const int i = tid + 512 * k; if (i < CW * CC / 4) *(LAS f32x4*)(WDW + 4 * i) = tw[k]; } }
        float bdw[8], gcn[8], bcn[8];
#pragma unroll
        for (int e = 0; e < 8; ++e) { bdw[e] = b_dw[8 * lane + e]; gcn[e] = g_cn[8 * lane + e]; bcn[e] = b_cn[8 * lane + e]; }
        const bool prun = (rep_ == 0) && ((MK_DUP >> 5) & 1);
        const bool p_nofill = prun && ((MK_DUP >> 22) & 1), p_nocomp = prun && ((MK_DUP >> 23) & 1);
        for (int it = (prun && ((MK_DUP >> 19) & 1)) ? vcu + 512 : vcu; it < ((prun && ((MK_DUP >> 18) & 1)) ? 512 : 512 + 2 * SBATCH); it += G) {
            __syncthreads();
            if (it < 512) { const int r0 = it * 32, b = r0 >> 11, s0 = r0 & (SEQ - 1);
                v4u tmp[8];
                if (!p_nofill) {
#pragma unroll
                for (int k = 0; k < 8; ++k) { const int i = tid + 512 * k, lr = (i >> 6) < 61 ? (i >> 6) : 61, ch = i & 63, s = s0 - CST + lr;
                    const v4u v = *(const v4u*)(U + ((size_t)b * SEQ + (s >= 0 ? s : 0)) * CC + ch * 8); tmp[k] = (s >= 0) ? v : (v4u){0u, 0u, 0u, 0u}; } }
#pragma unroll
                for (int k = 0; k < 8; ++k) { const int i = tid + 512 * k; if (i < 62 * 64 && !p_nofill) *(LAS v4u*)(UH + (i >> 6) * 1024 + (i & 63) * 16) = tmp[k]; }
                __syncthreads();
                if (!p_nocomp) att::mix_rows<4, false>(UH, WDW, wave * 4, (size_t)r0 + wave * 4, bdw, gcn, bcn, OMLA, MIX, lane);
            } else { const int bs = (it - 512) >> 1, half = (it - 512) & 1;
                v4u tmp[5];
#pragma unroll
                for (int k = 0; k < 5; ++k) { const int i = tid + 512 * k, lr = (i >> 6) < 37 ? (i >> 6) : 37, ch = i & 63, ci = 8 * half + lr;
                    const float* sp = st_conv + ((size_t)bs * CST + (ci < CST ? ci : CST - 1)) * CC + ch * 8; const f32x4 a = *(const f32x4*)sp, c = *(const f32x4*)(sp + 4);
                    const v4u uu = *(const v4u*)(U + ((size_t)TP + bs * SSEQ + (ci >= CST ? ci - CST : 0)) * CC + ch * 8);
                    v4u v; v.x = pk2(a.x, a.y); v.y = pk2(a.z, a.w); v.z = pk2(c.x, c.y); v.w = pk2(c.z, c.w);
                    tmp[k] = (ci < CST) ? v : uu; }
#pragma unroll
                for (int k = 0; k < 5; ++k) { const int i = tid + 512 * k; if (i < 38 * 64) *(LAS v4u*)(UH + (i >> 6) * 1024 + (i & 63) * 16) = tmp[k]; }
                __syncthreads();
                att::mix_rows<1, true>(UH, WDW, wave, (size_t)TP + bs * SSEQ + 8 * half + wave, bdw, gcn, bcn, OMLA, MIX, lane, PART, ML);
            }
        }
        if (BOTH(5)) { pg8::PanelSplitOrder S6; S6.init(G, (int)blockIdx.x, DM, MT6); pg8::EpiWo E6{x_p, HB, SSQ_H, (float*)(ws + WS_SLAB6), MT6, 0}; PRELOAD(S6, E6, preacc); GRID_BAR(); }
    }
    if (IN(6)) {
        pg8::Gemm g{MIX, Wo_t, T, DM, DM}; pg8::PanelSplitOrder S; S.init(G, (int)blockIdx.x, DM, MT6);
        if ((MK_DUP >> 6) & 1) { pg8::PanelSplitOrder Sd; Sd.init(G, (int)blockIdx.x, DM, MT6, ((MK_DUP >> 15) & 1) == 0); pg8::EpiWo Ed{x_p, HB, (float*)(ws + WS_ML), (float*)(ws + WS_SLAB6), MT6, (MK_DUP >> 12) & 7};
            pg8::gemm_phase<pg8::EpiWo, pg8::PanelSplitOrder, true, true>(ldsp + RING_OFF, g, Sd, Ed, preacc, false); GRID_BAR(); }
        pg8::EpiWo E{x_p, HB, SSQ_H, (float*)(ws + WS_SLAB6), MT6, 0};
        pg8::gemm_phase<pg8::EpiWo, pg8::PanelSplitOrder, true, true>(ldsp + RING_OFF, g, S, E, preacc, IN(5) && MK_DUP == 0);
        if (BOTH(6)) GRID_BAR();
    }
    if (IN(7)) {
        PHASE_IDS();
        for (int r = gw; r < TS; r += NGW) { const GAS f32x4* xr = (const GAS f32x4*)(x_s + (size_t)r * DM) + lane; f32x4 v[4]; float s = 0.f;
#pragma unroll
            for (int j = 0; j < 4; ++j) v[j] = xr[64 * j];
            for (int sl = 0; sl < DM / 64 / MT6; ++sl) { const GAS f32x4* sr = (const GAS f32x4*)((const float*)(ws + WS_SLAB6) + ((size_t)sl * 256 + r) * DM) + lane;
#pragma unroll
                for (int j = 0; j < 4; ++j) v[j] += sr[64 * j]; }
            GAS unsigned long long* o8 = (GAS unsigned long long*)(HB + ((size_t)TP + r) * DM) + lane;
#pragma unroll
            for (int j = 0; j < 4; ++j) { s += (v[j].x * v[j].x + v[j].y * v[j].y) + (v[j].z * v[j].z + v[j].w * v[j].w); o8[64 * j] = (unsigned long long)pk2(v[j].x, v[j].y) | ((unsigned long long)pk2(v[j].z, v[j].w) << 32); }
            s = att::wave_sum(s); if (lane == 0) SSQ_H[TP + r] = s; }
        if (BOTH(7)) GRID_BAR();
    }
    if (IN(8)) {
        pg8::Gemm g{HB, Wgu_t, T, NGU, DM}; pg8::StaticOrder S; S.init(T, NGU, G, (int)blockIdx.x);
        if ((MK_DUP >> 8) & 1) { pg8::EpiGU Ed{ACT, SSQ_H, (MK_DUP >> 12) & 7};
            pg8::gemm_phase<pg8::EpiGU, pg8::StaticOrder, true, true>(ldsp + RING_OFF, g, S, Ed, preacc, false); GRID_BAR(); }
        pg8::EpiGU E{ACT, SSQ_H, 0};
        pg8::gemm_phase<pg8::EpiGU, pg8::StaticOrder, true, true>(ldsp + RING_OFF, g, S, E, preacc, false);
        if (BOTH(8)) { pg8::PanelSplitOrder S9; S9.init(G, (int)blockIdx.x, DFF, MT8); pg8::EpiDown E9{(bf16*)(ws + WS_H2), HB, (float*)(ws + WS_SLAB8), MT8}; PRELOAD(S9, E9, preacc9); GRID_BAR(); }
    }
    if (IN(9)) {
        pg8::Gemm g{ACT, Wd_t, T, DM, DFF}; pg8::PanelSplitOrder S; S.init(G, (int)blockIdx.x, DFF, MT8);
        if ((MK_DUP >> 9) & 1) { pg8::PanelSplitOrder Sd; Sd.init(G, (int)blockIdx.x, DFF, MT8, ((MK_DUP >> 15) & 1) == 0); pg8::EpiDown Ed{(bf16*)(ws + WS_H2), HB, (float*)(ws + WS_SLAB8), MT8};
            pg8::gemm_phase<pg8::EpiDown, pg8::PanelSplitOrder, true, true>(ldsp + RING_OFF, g, Sd, Ed, preacc, false); GRID_BAR(); }
        pg8::EpiDown E{(bf16*)(ws + WS_H2), HB, (float*)(ws + WS_SLAB8), MT8};
        pg8::gemm_phase<pg8::EpiDown, pg8::PanelSplitOrder, true, true>(ldsp + RING_OFF, g, S, E, preacc9, IN(8) && MK_DUP == 0);
        if (BOTH(9)) GRID_BAR();
    }
    if (IN(10)) {
        PHASE_IDS();
        bf16* H2 = (bf16*)(ws + WS_H2);
        if ((MK_DUP >> 10) & 1) { for (int m = gw; m < T; m += NGW) rms_row(nullptr, g_final, nullptr, (float*)(ws + WS_XN) + (size_t)m * DM, lane, m >= TP ? (const float*)(ws + WS_SLAB8) + (size_t)(m - TP) * DM : nullptr, DFF / 64 / MT8, m >= TP ? HB + (size_t)m * DM : H2 + (size_t)m * DM); GRID_BAR(); }
        for (int m = gw; m < TP; m += 2 * NGW) { const int m2 = (m + NGW < TP) ? m + NGW : m; rms_rows2<true, false>(H2 + (size_t)m * DM, H2 + (size_t)m2 * DM, g_final, Y + (size_t)m * DM, Y + (size_t)m2 * DM, lane); }
        for (int m = TP + gw; m < T; m += NGW) rms_row(nullptr, g_final, nullptr, Y + (size_t)m * DM, lane, (const float*)(ws + WS_SLAB8) + (size_t)(m - TP) * DM, DFF / 64 / MT8, HB + (size_t)m * DM);
    }
#undef IN
#undef BOTH
}

extern "C" void kernel_launch(void* const* d_in, const int* in_sizes, int n_in, void* d_out, int out_size, void* d_ws, size_t ws_size, hipStream_t stream) {
    static int grid = 0;
    if (grid == 0) {
        if (n_in != 24 || in_sizes[0] != TP * DM || (size_t)out_size != O_END || ws_size < WS_END) { fprintf(stderr, "kernel_launch: shape mismatch (n_in %d, in0 %d, out %d, ws %zu); nothing launched\n", n_in, n_in > 0 ? in_sizes[0] : -1, out_size, ws_size); grid = -1; return; }
        int dev = 0, cus = 0, per_cu = 0;
        if (hipGetDevice(&dev) != hipSuccess || hipDeviceGetAttribute(&cus, hipDeviceAttributeMultiprocessorCount, dev) != hipSuccess) { fprintf(stderr, "kernel_launch: device query failed\n"); grid = -1; return; }
        if (hipFuncSetAttribute((const void*)mk_fwd, hipFuncAttributeMaxDynamicSharedMemorySize, LDS_BYTES) != hipSuccess) { fprintf(stderr, "kernel_launch: hipFuncSetAttribute failed\n"); grid = -1; return; }
        if (hipOccupancyMaxActiveBlocksPerMultiprocessor(&per_cu, (const void*)mk_fwd, NWAVES * 64, LDS_BYTES) != hipSuccess || per_cu < 1) { fprintf(stderr, "kernel_launch: occupancy query says %d workgroups per CU; nothing launched\n", per_cu); (void)hipGetLastError(); grid = -1; return; }
        grid = cus;
    }
    if (grid < 0) return;
    if (hipMemsetAsync((char*)d_ws + WS_CTL, 0, CTL_ZERO_BYTES, stream) != hipSuccess) { fprintf(stderr, "kernel_launch: hipMemsetAsync failed\n"); return; }
    Args a{};
    for (int i = 0; i < 24; ++i) a.in[i] = (const float*)d_in[i];
    a.out = (float*)d_out; a.ws = (unsigned char*)d_ws;
    for (int li = 0; li < N_LAUNCHES; ++li) {
        a.ph_lo = (N_LAUNCHES == NPHASE) ? li : 0; a.ph_hi = (N_LAUNCHES == NPHASE) ? li + 1 : NPHASE;
        hipLaunchKernelGGL(mk_fwd, dim3(grid), dim3(NWAVES * 64), LDS_BYTES, stream, a);
        const hipError_t le = hipPeekAtLastError();
        if (le != hipSuccess) { fprintf(stderr, "kernel_launch: launch %d failed: %s\n", li, hipGetErrorName(le)); break; }
    }
}
```
